# Optimizing an MI355X kernel written in HIP

```python
import math
import jax
import jax.numpy as jnp
from jax import lax
import numpy as np

D_MODEL = 1024
BATCH = 8
SEQ = 2048
DEPTH = 4

HEAD_DIM = 64
H_SB = 4
H_DIFF = 4
DIFF_QK_DIM = HEAD_DIM // 2
DIFF_V_DIM = HEAD_DIM
H_DSA = 4
IDX_HEADS = 8
IDX_DIM = 64
DSA_TOPK_MAX = 256
H_MOBA = 4
MOBA_BLOCK = 256
MOBA_TOPK = 3
N_BRANCH = 4
N_SOFTMAX_HEADS = H_DIFF + H_DSA + H_MOBA
N_BUCKETS = 32
MAX_DISTANCE = 128
Q_BLOCK = 128
D_FF = ((8 * D_MODEL + 3 * 256 - 1) // (3 * 256)) * 256
NORM_EPS = 1e-6
N_IN = (3 * H_SB * HEAD_DIM + H_DIFF * (4 * DIFF_QK_DIM + DIFF_V_DIM) + 3 * H_DSA * HEAD_DIM + IDX_HEADS * IDX_DIM + IDX_DIM + IDX_HEADS + 3 * H_MOBA * HEAD_DIM + N_BRANCH * D_MODEL)

kernel_name = 'hybrid_gated_sparse_trunk'


def _rms_norm(x, g):
    xf = x.astype(jnp.float32)
    y = xf * lax.rsqrt(jnp.mean(xf * xf, axis=-1, keepdims=True) + NORM_EPS)
    return (y * g.astype(jnp.float32)).astype(x.dtype)


def _split_sizes():
    hd = HEAD_DIM
    return ((H_SB * hd,) * 3
            + (H_DIFF * DIFF_QK_DIM,) * 4 + (H_DIFF * DIFF_V_DIM,)
            + (H_DSA * hd,) * 3 + (IDX_HEADS * IDX_DIM, IDX_DIM, IDX_HEADS)
            + (H_MOBA * hd,) * 3
            + (N_BRANCH * D_MODEL,))


def _split_columns(z):
    points, acc = [], 0
    for sz in _split_sizes()[:-1]:
        acc += sz
        points.append(acc)
    return jnp.split(z, points, axis=-1)


def _seq_blocks(t):
    b, s = t.shape[:2]
    t = t.reshape((b, s // Q_BLOCK, Q_BLOCK) + t.shape[2:])
    return jnp.moveaxis(t, 1, 0)


def _merge_blocks(t):
    t = jnp.moveaxis(t, 0, 1)
    return t.reshape((t.shape[0], t.shape[1] * t.shape[2]) + t.shape[3:])


def _t5_bucket(dist):
    max_exact = N_BUCKETS // 2
    d = jnp.maximum(dist, 0)
    log_ratio = jnp.log(jnp.maximum(d, 1).astype(jnp.float32) / max_exact) / math.log(MAX_DISTANCE / max_exact)
    large = jnp.minimum(max_exact + (log_ratio * (N_BUCKETS - max_exact)).astype(jnp.int32), N_BUCKETS - 1)
    return jnp.where(d < max_exact, d, large)


def _t5_bias(table, dist):
    return jnp.moveaxis(table.astype(jnp.float32)[_t5_bucket(dist)], -1, 0)


def _stick_breaking_attention(q, k, v):
    s = q.shape[1]
    pos = jnp.arange(s, dtype=jnp.int32)
    scale = HEAD_DIM ** -0.5

    def block(args):
        qb, qpos = args
        z = jnp.einsum('bqhd,bkhd->bhqk', qb, k).astype(jnp.float32) * scale
        strict = pos[None, :] < qpos[:, None]
        sp = jnp.where(strict, jax.nn.softplus(z), 0.0)
        tail = lax.cumsum(sp, axis=3, reverse=True) - sp
        a = jnp.where(strict, jnp.exp(jax.nn.log_sigmoid(z) - tail), 0.0)
        return jnp.einsum('bhqk,bkhd->bqhd', a.astype(v.dtype), v)

    return _merge_blocks(lax.map(block, (_seq_blocks(q), pos.reshape(-1, Q_BLOCK))))


def _differential_attention(q1, q2, k1, k2, v, lam, bias_table):
    s = q1.shape[1]
    pos = jnp.arange(s, dtype=jnp.int32)
    scale = DIFF_QK_DIM ** -0.5

    def block(args):
        qb1, qb2, qpos = args
        causal = pos[None, :] <= qpos[:, None]
        bias = _t5_bias(bias_table, qpos[:, None] - pos[None, :])

        def probs(qb, kk):
            lg = jnp.einsum('bqhd,bkhd->bhqk', qb, kk).astype(jnp.float32) * scale + bias
            return jax.nn.softmax(jnp.where(causal, lg, -jnp.inf), axis=-1)

        w = probs(qb1, k1) - lam * probs(qb2, k2)
        return jnp.einsum('bhqk,bkhd->bqhd', w.astype(v.dtype), v)

    return _merge_blocks(lax.map(block, (_seq_blocks(q1), _seq_blocks(q2), pos.reshape(-1, Q_BLOCK))))


def _dsa_attention(q, k, v, q_idx, k_idx, w_idx, bias_table):
    s = q.shape[1]
    pos = jnp.arange(s, dtype=jnp.int32)
    topk = min(DSA_TOPK_MAX, s // 4)
    scale = HEAD_DIM ** -0.5
    gather = jax.vmap(lambda t, i: t[i])

    def block(args):
        qb, qib, wb, qpos = args
        rel = jax.nn.relu(jnp.einsum('bqhd,bkd->bqhk', qib, k_idx).astype(jnp.float32) * IDX_DIM ** -0.5)
        score = jnp.einsum('bqh,bqhk->bqk', wb.astype(jnp.float32), rel)
        score = jnp.where((pos[None, :] <= qpos[:, None])[None], score, -jnp.inf)
        top_score, sel = lax.top_k(score, topk)
        valid = (top_score > -jnp.inf)[:, None]
        kg = gather(k, sel)
        vg = gather(v, sel)
        bias = jnp.moveaxis(bias_table.astype(jnp.float32)[_t5_bucket(qpos[None, :, None] - sel)], -1, 1)
        lg = jnp.einsum('bqhd,bqkhd->bhqk', qb, kg).astype(jnp.float32) * scale + bias
        p = jax.nn.softmax(jnp.where(valid, lg, -jnp.inf), axis=-1)
        return jnp.einsum('bhqk,bqkhd->bqhd', p.astype(v.dtype), vg)

    xs = (_seq_blocks(q), _seq_blocks(q_idx), _seq_blocks(w_idx), pos.reshape(-1, Q_BLOCK))
    return _merge_blocks(lax.map(block, xs))


def _moba_attention(q, k, v, bias_table):
    b, s, h, d = q.shape
    pos = jnp.arange(s, dtype=jnp.int32)
    nblk = -(-s // MOBA_BLOCK)
    pad = nblk * MOBA_BLOCK - s

    def to_blocks(t):
        t = jnp.pad(jnp.swapaxes(t, 1, 2), ((0, 0), (0, 0), (0, pad), (0, 0)))
        return t.reshape(b, h, nblk, MOBA_BLOCK, d)

    kb, vb = to_blocks(k), to_blocks(v)
    kmean = jnp.mean(kb, axis=3)
    topb = min(MOBA_TOPK, nblk - 1)
    head_ids = jnp.arange(h)
    in_blk = jnp.arange(MOBA_BLOCK, dtype=jnp.int32)
    scale = d ** -0.5
    gather = jax.vmap(jax.vmap(lambda t, i: t[i]))
    table_t = bias_table.astype(jnp.float32).T

    def block(args):
        qb, qpos = args
        own = qpos[0] // MOBA_BLOCK
        k_own = lax.dynamic_index_in_dim(kb, own, axis=2, keepdims=False)
        v_own = lax.dynamic_index_in_dim(vb, own, axis=2, keepdims=False)
        own_pos = own * MOBA_BLOCK + in_blk
        lg_own = (jnp.einsum('bqhd,bhkd->bhqk', qb, k_own).astype(jnp.float32) * scale
                  + _t5_bias(bias_table, qpos[:, None] - own_pos[None, :]))
        lg_own = jnp.where(own_pos[None, :] <= qpos[:, None], lg_own, -jnp.inf)
        if topb == 0:
            p = jax.nn.softmax(lg_own, axis=-1)
            return jnp.einsum('bhqk,bhkd->bqhd', p.astype(v.dtype), v_own)
        gate = jnp.einsum('bqhd,bhnd->bhqn', qb, kmean).astype(jnp.float32)
        gate = jnp.where(jnp.arange(nblk) < own, gate, -jnp.inf)
        g_score, sel = lax.top_k(gate, topb)
        valid = (g_score > -jnp.inf)[..., None]
        kg = gather(kb, sel)
        vg = gather(vb, sel)
        past_pos = sel[..., None] * MOBA_BLOCK + in_blk
        bias_past = table_t[head_ids[None, :, None, None, None], _t5_bucket(qpos[None, None, :, None, None] - past_pos)]
        lg_past = jnp.einsum('bqhd,bhqnkd->bhqnk', qb, kg).astype(jnp.float32) * scale + bias_past
        lg_past = jnp.where(valid, lg_past, -jnp.inf)
        nq = qb.shape[1]
        p = jax.nn.softmax(jnp.concatenate([lg_past.reshape(b, h, nq, topb * MOBA_BLOCK), lg_own], axis=-1), axis=-1)
        p_past = p[..., :topb * MOBA_BLOCK].reshape(b, h, nq, topb, MOBA_BLOCK).astype(v.dtype)
        p_own = p[..., topb * MOBA_BLOCK:].astype(v.dtype)
        return (jnp.einsum('bhqnk,bhqnkd->bqhd', p_past, vg)
                + jnp.einsum('bhqk,bhkd->bqhd', p_own, v_own))

    return _merge_blocks(lax.map(block, (_seq_blocks(q), pos.reshape(-1, Q_BLOCK))))


def _token_mixers(h, w_in, w_br_sb, w_br_diff, w_br_dsa, w_br_moba, w_out, lam, lam_init, diff_subln_g, rel_bias):
    b, s, _ = h.shape
    (q_sb, k_sb, v_sb, q1, q2, k1, k2, v_df, q_ds, k_ds, v_ds, qi_ds, ki_ds, wi_ds,
     q_mb, k_mb, v_mb, gate_logits) = _split_columns(h @ w_in)

    def heads(t, n):
        return t.reshape(b, s, n, -1)

    def flat(t):
        return t.reshape(b, s, -1)

    bias_df = rel_bias[:, :H_DIFF]
    bias_ds = rel_bias[:, H_DIFF:H_DIFF + H_DSA]
    bias_mb = rel_bias[:, H_DIFF + H_DSA:]
    o_sb = _stick_breaking_attention(heads(q_sb, H_SB), heads(k_sb, H_SB), heads(v_sb, H_SB))
    o_df = _differential_attention(heads(q1, H_DIFF), heads(q2, H_DIFF), heads(k1, H_DIFF), heads(k2, H_DIFF),
                                   heads(v_df, H_DIFF), lam, bias_df)
    o_df = _rms_norm(o_df, diff_subln_g) * (1.0 - lam_init)
    o_ds = _dsa_attention(heads(q_ds, H_DSA), heads(k_ds, H_DSA), heads(v_ds, H_DSA),
                          heads(qi_ds, IDX_HEADS), ki_ds, wi_ds * IDX_HEADS ** -0.5, bias_ds)
    o_mb = _moba_attention(heads(q_mb, H_MOBA), heads(k_mb, H_MOBA), heads(v_mb, H_MOBA), bias_mb)
    g = jax.nn.sigmoid(gate_logits.astype(jnp.float32)).astype(h.dtype).reshape(b, s, N_BRANCH, D_MODEL)
    merged = (g[:, :, 0] * (flat(o_sb) @ w_br_sb)
              + g[:, :, 1] * (flat(o_df) @ w_br_diff)
              + g[:, :, 2] * (flat(o_ds) @ w_br_dsa)
              + g[:, :, 3] * (flat(o_mb) @ w_br_moba))
    return merged @ w_out


def _swiglu(h, w_ffn_in, w_ffn_out):
    gate, up = jnp.split(h @ w_ffn_in, 2, axis=-1)
    return (jax.nn.silu(gate) * up) @ w_ffn_out


def setup_inputs(seed: int = 0) -> dict:
    key = jax.random.key(seed)
    ks = jax.random.split(key, 19)
    f32 = jnp.float32

    def nrm(k, shape, fan_in):
        return jax.random.normal(k, shape, f32) * fan_in ** -0.5

    def gain(k, shape):
        return 1.0 + 0.05 * jax.random.normal(k, shape, f32)

    br_in = HEAD_DIM * 4
    return {
        'x': jax.random.normal(ks[0], (BATCH, SEQ, D_MODEL), f32),
        'w_in': nrm(ks[1], (DEPTH, D_MODEL, N_IN), D_MODEL),
        'w_br_sb': nrm(ks[2], (DEPTH, H_SB * HEAD_DIM, D_MODEL), br_in),
        'w_br_diff': nrm(ks[3], (DEPTH, H_DIFF * DIFF_V_DIM, D_MODEL), br_in),
        'w_br_dsa': nrm(ks[4], (DEPTH, H_DSA * HEAD_DIM, D_MODEL), br_in),
        'w_br_moba': nrm(ks[5], (DEPTH, H_MOBA * HEAD_DIM, D_MODEL), br_in),
        'w_out': nrm(ks[6], (DEPTH, D_MODEL, D_MODEL), D_MODEL),
        'lambda_q1': 0.1 * jax.random.normal(ks[7], (DEPTH, DIFF_QK_DIM), f32),
        'lambda_k1': 0.1 * jax.random.normal(ks[8], (DEPTH, DIFF_QK_DIM), f32),
        'lambda_q2': 0.1 * jax.random.normal(ks[9], (DEPTH, DIFF_QK_DIM), f32),
        'lambda_k2': 0.1 * jax.random.normal(ks[10], (DEPTH, DIFF_QK_DIM), f32),
        'diff_subln_g': gain(ks[11], (DEPTH, DIFF_V_DIM)),
        'rel_bias': 0.1 * jax.random.normal(ks[12], (N_BUCKETS, N_SOFTMAX_HEADS), f32),
        'w_ffn_in': nrm(ks[13], (DEPTH, D_MODEL, 2 * D_FF), D_MODEL),
        'w_ffn_out': nrm(ks[14], (DEPTH, D_FF, D_MODEL), D_FF),
        'g_pre_mix': gain(ks[15], (DEPTH, D_MODEL)),
        'g_post_mix': gain(ks[16], (DEPTH, D_MODEL)),
        'g_pre_ffn': gain(ks[17], (DEPTH, D_MODEL)),
        'g_post_ffn': gain(ks[18], (DEPTH, D_MODEL)),
    }


def reference(x, w_in, w_br_sb, w_br_diff, w_br_dsa, w_br_moba, w_out, lambda_q1, lambda_k1, lambda_q2, lambda_k2,
              diff_subln_g, rel_bias, w_ffn_in, w_ffn_out, g_pre_mix, g_post_mix, g_pre_ffn, g_post_ffn):
    f32 = jnp.float32
    for l in range(DEPTH):
        lam_init = 0.8 - 0.6 * math.exp(-0.3 * l)
        lam = (jnp.exp(jnp.sum(lambda_q1[l].astype(f32) * lambda_k1[l].astype(f32)))
               - jnp.exp(jnp.sum(lambda_q2[l].astype(f32) * lambda_k2[l].astype(f32))) + lam_init)
        h = _rms_norm(x, g_pre_mix[l])
        y = _token_mixers(h, w_in[l], w_br_sb[l], w_br_diff[l], w_br_dsa[l], w_br_moba[l], w_out[l],
                          lam, lam_init, diff_subln_g[l], rel_bias)
        x = x + _rms_norm(y, g_post_mix[l])
        h = _rms_norm(x, g_pre_ffn[l])
        x = x + _rms_norm(_swiglu(h, w_ffn_in[l], w_ffn_out[l]), g_post_ffn[l])
    return x
```

```cpp
#include <hip/hip_runtime.h>
#include <cstdio>
#include <cstdint>

#ifndef MK_ONE_LAUNCH
#define MK_ONE_LAUNCH 1
#endif

#ifndef PH_ENABLE
#define PH_ENABLE 0xFFFFFFFFu
#endif
#define PHEN(k) (((PH_ENABLE) >> (k)) & 1u)
#define DI __device__ __forceinline__
#define LAS __attribute__((address_space(3)))
typedef unsigned short bf16_t;
typedef short bf16x8 __attribute__((ext_vector_type(8)));
typedef short s16x4 __attribute__((ext_vector_type(4)));
typedef float f32x2 __attribute__((ext_vector_type(2)));
typedef float f32x4 __attribute__((ext_vector_type(4)));
typedef float f32x16 __attribute__((ext_vector_type(16)));
typedef unsigned u32x2 __attribute__((ext_vector_type(2)));
typedef unsigned u32x4 __attribute__((ext_vector_type(4)));
typedef __bf16 bf2_t __attribute__((ext_vector_type(2)));

constexpr int BATCH = 8, SEQ = 2048, DM = 1024, NL = 4, M = BATCH * SEQ;
constexpr int N_IN = 7752;
constexpr int NZ = 7936;
constexpr int NZG = 3840;
constexpr int DFF = 2816, NF1 = 2 * DFF;
constexpr float EPS = 1e-6f;
constexpr float LOG2E = 1.4426950408889634f;
constexpr int ZC_QSB = 0, ZC_KSB = 256, ZC_VSB = 512, ZC_QD = 768, ZC_KD = 1024, ZC_VD = 1280, ZC_QDS = 1536, ZC_KDS = 1792, ZC_VDS = 2048,
              ZC_QMB = 2304, ZC_KMB = 2560, ZC_VMB = 2816, ZC_QI = 3072, ZC_KI = 3584, ZC_WI = 3648;
constexpr int OC_SB = 0, OC_DF = 256, OC_DS = 512, OC_MB = 768;

constexpr size_t al256(size_t x) { return (x + 255) & ~(size_t)255; }
constexpr size_t WS_CTL = 0, CTL_BYTES = 1u << 20;
constexpr size_t SZ_WIN = (size_t)NL * NZ * DM * 2, SZ_WBR = (size_t)NL * 4 * DM * 256 * 2, SZ_WOUT = (size_t)NL * DM * DM * 2,
                 SZ_WF1 = (size_t)NL * NF1 * DM * 2, SZ_WF2 = (size_t)NL * DM * DFF * 2;
constexpr size_t WS_WIN = WS_CTL + CTL_BYTES;
constexpr size_t WS_WBR = WS_WIN + SZ_WIN;
constexpr size_t WS_WOUT = WS_WBR + SZ_WBR;
constexpr size_t WS_WF1 = WS_WOUT + SZ_WOUT;
constexpr size_t WS_WF2 = WS_WF1 + SZ_WF1;
constexpr size_t WS_H = WS_WF2 + SZ_WF2;
constexpr int NZQ = NZG, NZGW = 4096;
constexpr size_t WS_ZQ = WS_H + (size_t)M * DM * 2, SZ_ZQ = (size_t)M * NZQ * 2;
constexpr size_t WS_ZG = WS_ZQ + SZ_ZQ, SZ_ZG = (size_t)M * NZGW * 2;
constexpr size_t WS_O = WS_ZG + SZ_ZG;
constexpr size_t WS_MASK = WS_O + (size_t)M * DM * 2;
constexpr size_t WS_KMEAN = WS_MASK + (size_t)M * 256;
constexpr size_t WS_NEED = WS_KMEAN + (size_t)BATCH * 8 * 256 * 4;
constexpr size_t WS_MF = WS_ZQ;
constexpr size_t WS_MB = WS_ZQ + (size_t)M * DM * 4;
constexpr size_t WS_Y1 = WS_ZG;
constexpr size_t WS_ACT = WS_ZG;
constexpr size_t WS_Y2 = WS_ZQ;
static_assert((size_t)M * DM * 6 <= SZ_ZQ && (size_t)M * DFF * 2 <= SZ_ZG && (size_t)M * DM * 4 <= SZ_ZG, "overlays fit");

constexpr int CW_BAR = 4096;

constexpr int LDS_SCR = 0, LDS_SCR_BYTES = 131584;
constexpr int LDS_CTL = LDS_SCR_BYTES;
constexpr int LDS_BYTES = LDS_CTL + 256;

DI unsigned pk2(float lo, float hi) { f32x2 v = {lo, hi}; return __builtin_bit_cast(unsigned, __builtin_convertvector(v, bf2_t)); }
DI float bf2f(unsigned short b) { return __uint_as_float((unsigned)b << 16); }
DI float bflo(unsigned w) { return __uint_as_float(w << 16); }
DI float bfhi(unsigned w) { return __uint_as_float(w & 0xffff0000u); }
DI float ex2(float x) { return __builtin_amdgcn_exp2f(x); }
DI float lg2(float x) { return __builtin_amdgcn_logf(x); }
DI float rcpf(float x) { return __builtin_amdgcn_rcpf(x); }
DI float sigmoidf_(float x) { return rcpf(1.0f + ex2(-x * LOG2E)); }
DI float wave_sum(float v) {
#pragma unroll
    for (int o = 1; o < 64; o <<= 1) v += __shfl_xor(v, o);
    return v;
}
DI float other_half(float v) {
    auto rr = __builtin_amdgcn_permlane32_swap(__float_as_uint(v), __float_as_uint(v), false, false);
    return (threadIdx.x & 32) ? __uint_as_float(rr[0]) : __uint_as_float(rr[1]);
}

namespace pg8 {
constexpr int BM = 256, BK = 64, HALF = 128, HTB = HALF * BK * 2, STAGE_BYTES = 8 * HTB, NXCD = 8, WGM = 8;
__host__ __device__ __forceinline__ int lds_byte(int r, int c) { const int st = (r >> 4) * 2 + (c >> 5), rr = r & 15, cc = c & 31, ob = rr * 64 + cc * 2; return st * 1024 + (ob ^ (((ob >> 9) & 1) << 5)); }
__host__ __device__ __forceinline__ void stage_rc(int b, int& R, int& C) { const int st = b / 1024, sb = b % 1024, swz = sb ^ (((sb >> 9) & 1) << 5); R = (st >> 1) * 16 + swz / 64; C = (st & 1) * 32 + (swz % 64) / 2; }
__host__ __device__ __forceinline__ int perm32(int rho) { const int n = rho >> 4, i = rho & 15; return 8 * (i >> 2) + 4 * n + (i & 3); }
struct Unit { int pm, pn; };
struct Gemm { const bf16_t* A; const bf16_t* Bt; int M, N, K, lda, ldb; };
struct StaticOrder {
    int nM, nN, nwg, G, c;
    __host__ __device__ void init(int M_, int N_, int G_, int c_) { nM = M_ / BM; nN = N_ / BM; nwg = nM * nN; G = G_; c = c_; }
    __host__ __device__ bool next(int i, Unit& u) const {
        const long L = (long)i * G + c; if (L >= nwg) return false;
        int wgid = (int)L; { const int q = nwg / NXCD, r = nwg % NXCD, xcd = wgid % NXCD, off = wgid / NXCD; wgid = (xcd < r ? xcd * (q + 1) : r * (q + 1) + (xcd - r) * q) + off; }
        const int nig = WGM * nN, gid = wgid / nig, fm = gid * WGM, gsz = (nM - fm) < WGM ? (nM - fm) : WGM;
        u.pm = fm + ((wgid % nig) % gsz); u.pn = (wgid % nig) / gsz; return true;
    }
};
template <class Epi>
__device__ __forceinline__ void gemm_phase(LAS unsigned char* lds, Gemm g, const StaticOrder& S, const Epi& E) {
    { size_t zo = 0; asm volatile("" : "+s"(zo), "+s"(g.K), "+s"(g.lda), "+s"(g.ldb)); g.A += zo; g.Bt += zo; }
    int tid_ = threadIdx.x; asm volatile("" : "+v"(tid_));
    const int tid = tid_, wid = __builtin_amdgcn_readfirstlane(tid >> 6), lane = tid & 63, wr = wid >> 2, wc = wid & 3, fr = lane & 15, fq = lane >> 4;
    const int K = g.K, nt = K / BK;
    unsigned voffA[2], voffB[2];
#pragma unroll
    for (int i = 0; i < 2; ++i) { int R, C; stage_rc(tid * 16 + i * 8192, R, C); const int Rb = Epi::PERM ? ((R & ~31) + perm32(R & 31)) : R;
        voffA[i] = (unsigned)(R * g.lda + C) * 2u; voffB[i] = (unsigned)(Rb * g.ldb + C) * 2u; }
    const size_t kstep = (size_t)(BK * 2);
    const size_t hstepA = (size_t)HALF * g.lda * 2, hstepB = (size_t)HALF * g.ldb * 2;
    const size_t tstepA = 2 * hstepA, tstepB = 2 * hstepB;
    const unsigned ldsw = (unsigned)wid * 1024u;
    const int aoff = lds_byte(wr * 64 + fr, fq * 8), boff = lds_byte(wc * 32 + fr, fq * 8);
#define PG8_SA(b, h) (((b) * 2 + (h)) * HTB)
#define PG8_SB(b, h) ((4 + (b) * 2 + (h)) * HTB)
#define PG8_STAGE(bufoff, gbase, voff) do { _Pragma("unroll") for (int _i = 0; _i < 2; ++_i) \
        __builtin_amdgcn_global_load_lds((const unsigned*)((const char*)(gbase) + (voff)[_i]), (LAS unsigned*)(lds + (bufoff) + ldsw + _i * 8192), 16, 0, 0); } while (0)
#define PG8_LDA(dst, b, h) do { _Pragma("unroll") for (int m = 0; m < 4; ++m) _Pragma("unroll") for (int k = 0; k < 2; ++k) dst[m][k] = *(const LAS bf16x8*)(lds + PG8_SA(b, h) + aoff + m * 2048 + k * 1024); } while (0)
#define PG8_LDB(dst, b, h) do { _Pragma("unroll") for (int n = 0; n < 2; ++n) _Pragma("unroll") for (int k = 0; k < 2; ++k) dst[n][k] = *(const LAS bf16x8*)(lds + PG8_SB(b, h) + boff + n * 2048 + k * 1024); } while (0)
#define PG8_MMA(ai, bj, At, Bt) do { __builtin_amdgcn_s_setprio(1); _Pragma("unroll") for (int m = 0; m < 4; ++m) _Pragma("unroll") for (int n = 0; n < 2; ++n) _Pragma("unroll") for (int k = 0; k < 2; ++k) \
        acc[ai][bj][m][n] = __builtin_amdgcn_mfma_f32_16x16x32_bf16(Bt[n][k], At[m][k], acc[ai][bj][m][n], 0, 0, 0); __builtin_amdgcn_s_setprio(0); } while (0)
#define PG8_WAIT_V(n) asm volatile("s_waitcnt vmcnt(" #n ")" ::: "memory")
#define PG8_WAIT_L(n) asm volatile("s_waitcnt lgkmcnt(" #n ")" ::: "memory")
#define PG8_BAR __builtin_amdgcn_s_barrier()
#define PG8_SCHED __builtin_amdgcn_sched_barrier(0)
    Unit cur, nxt; int ui = 0;
    if (!S.next(0, cur)) return;
    f32x4 acc[2][2][4][2];
#pragma unroll
    for (int a = 0; a < 2; ++a)
#pragma unroll
        for (int b = 0; b < 2; ++b)
#pragma unroll
            for (int m = 0; m < 4; ++m)
#pragma unroll
                for (int n = 0; n < 2; ++n) acc[a][b][m][n] = (f32x4){0.f, 0.f, 0.f, 0.f};
    bf16x8 At[4][2], B0[2][2], B1[2][2];
    const char* cA = (const char*)g.A + (size_t)cur.pm * tstepA; const char* cB = (const char*)g.Bt + (size_t)cur.pn * tstepB;
    PG8_STAGE(PG8_SB(0, 0), cB, voffB); PG8_STAGE(PG8_SA(0, 0), cA, voffA); PG8_STAGE(PG8_SB(0, 1), cB + hstepB, voffB); PG8_STAGE(PG8_SA(0, 1), cA + hstepA, voffA);
    if (wr == 1) PG8_BAR;
    PG8_WAIT_V(4); PG8_BAR;
    PG8_STAGE(PG8_SB(1, 0), cB + kstep, voffB); PG8_STAGE(PG8_SA(1, 0), cA + kstep, voffA); PG8_STAGE(PG8_SB(1, 1), cB + hstepB + kstep, voffB);
    PG8_WAIT_V(6); PG8_BAR;
    for (;;) {
        const bool has_next = S.next(ui + 1, nxt);
        const char* nA = has_next ? (const char*)g.A + (size_t)nxt.pm * tstepA : cA; const char* nB = has_next ? (const char*)g.Bt + (size_t)nxt.pn * tstepB : cB;
        for (int t = 0; t < nt; t += 2) {
            const bool last = (t == nt - 2);
            const char* a1 = cA + (size_t)(t + 1) * kstep;
            const char* a2 = last ? nA : cA + (size_t)(t + 2) * kstep; const char* b2 = last ? nB : cB + (size_t)(t + 2) * kstep;
            const char* a3 = a2 + kstep; const char* b3 = b2 + kstep;
            PG8_LDB(B0, 0, 0); PG8_SCHED; PG8_LDA(At, 0, 0); PG8_STAGE(PG8_SA(1, 1), a1 + hstepA, voffA);
            PG8_WAIT_L(8); PG8_BAR; PG8_WAIT_L(0); PG8_MMA(0, 0, At, B0); PG8_BAR; PG8_SCHED;
            PG8_LDB(B1, 0, 1); PG8_STAGE(PG8_SB(0, 0), b2, voffB);
            PG8_BAR; PG8_WAIT_L(0); PG8_MMA(0, 1, At, B1); PG8_BAR;
            PG8_LDA(At, 0, 1); PG8_STAGE(PG8_SA(0, 0), a2, voffA);
            PG8_BAR; PG8_WAIT_L(0); PG8_MMA(1, 0, At, B0); PG8_BAR; PG8_SCHED;
            PG8_STAGE(PG8_SB(0, 1), b2 + hstepB, voffB);
            PG8_WAIT_V(6); PG8_BAR; PG8_MMA(1, 1, At, B1); PG8_BAR;
            PG8_LDB(B0, 1, 0); PG8_SCHED; PG8_LDA(At, 1, 0); PG8_STAGE(PG8_SA(0, 1), a2 + hstepA, voffA);
            PG8_WAIT_L(8); PG8_BAR; PG8_WAIT_L(0); PG8_MMA(0, 0, At, B0); PG8_BAR; PG8_SCHED;
            PG8_LDB(B1, 1, 1); PG8_STAGE(PG8_SB(1, 0), b3, voffB);
            PG8_BAR; PG8_WAIT_L(0); PG8_MMA(0, 1, At, B1); PG8_BAR;
            PG8_LDA(At, 1, 1); PG8_STAGE(PG8_SA(1, 0), a3, voffA);
            PG8_BAR; PG8_WAIT_L(0); PG8_MMA(1, 0, At, B0); PG8_BAR; PG8_SCHED;
            PG8_STAGE(PG8_SB(1, 1), b3 + hstepB, voffB);
            PG8_WAIT_V(6); PG8_BAR; PG8_MMA(1, 1, At, B1); PG8_BAR;
        }
        E(acc, cur, wr, wc, fr, fq);
        if (!has_next) break;
#pragma unroll
        for (int a = 0; a < 2; ++a)
#pragma unroll
            for (int b = 0; b < 2; ++b)
#pragma unroll
                for (int m = 0; m < 4; ++m)
#pragma unroll
                    for (int n = 0; n < 2; ++n) acc[a][b][m][n] = (f32x4){0.f, 0.f, 0.f, 0.f};
        cur = nxt; cA = nA; cB = nB; ++ui;
    }
    PG8_WAIT_V(0);
    if (wr == 0) PG8_BAR;
    PG8_BAR;
#undef PG8_SA
#undef PG8_SB
#undef PG8_STAGE
#undef PG8_LDA
#undef PG8_LDB
#undef PG8_MMA
#undef PG8_WAIT_V
#undef PG8_WAIT_L
#undef PG8_BAR
#undef PG8_SCHED
}
}

struct EpiZ {
    static constexpr bool PERM = true;
    bf16_t* ZQ; bf16_t* ZG;
    DI void operator()(const f32x4 (&acc)[2][2][4][2], const pg8::Unit& u, int wr, int wc, int fr, int fq) const {
        asm volatile("" : "+v"(fr), "+v"(fq));
        const bool gate = u.pn >= NZG / 256;
        const int row0 = u.pm * 256 + wr * 64 + fr, col0 = (gate ? u.pn - NZG / 256 : u.pn) * 256 + wc * 32 + 8 * fq;
        bf16_t* Z = gate ? ZG : ZQ; const int ldz = gate ? NZGW : NZQ;
#pragma unroll
        for (int ai = 0; ai < 2; ++ai)
#pragma unroll
            for (int m = 0; m < 4; ++m) { bf16_t* rowp = Z + (size_t)(row0 + ai * 128 + m * 16) * ldz + col0;
#pragma unroll
                for (int bj = 0; bj < 2; ++bj) { f32x4 v0 = acc[ai][bj][m][0], v1 = acc[ai][bj][m][1];
                    if (gate) {
#pragma unroll
                        for (int j = 0; j < 4; ++j) { v0[j] = sigmoidf_(v0[j]); v1[j] = sigmoidf_(v1[j]); } }
                    u32x4 w; w.x = pk2(v0[0], v0[1]); w.y = pk2(v0[2], v0[3]); w.z = pk2(v1[0], v1[1]); w.w = pk2(v1[2], v1[3]);
                    *(u32x4*)(rowp + bj * 128) = w; } }
    }
};
template <int BR> struct EpiBranch {
    static constexpr bool PERM = true;
    const bf16_t* Z; float* MF; bf16_t* MB;
    DI void operator()(const f32x4 (&acc)[2][2][4][2], const pg8::Unit& u, int wr, int wc, int fr, int fq) const {
        asm volatile("" : "+v"(fr), "+v"(fq));
        const int row0 = u.pm * 256 + wr * 64 + fr, col0 = u.pn * 256 + wc * 32 + 8 * fq;
#pragma unroll
        for (int ai = 0; ai < 2; ++ai)
#pragma unroll
            for (int m = 0; m < 4; ++m) { const size_t row = (size_t)(row0 + ai * 128 + m * 16);
#pragma unroll
                for (int bj = 0; bj < 2; ++bj) { const int col = col0 + bj * 128;
                    const u32x4 gw = *(const u32x4*)(Z + row * NZGW + BR * 1024 + col);
                    f32x4 v0 = acc[ai][bj][m][0], v1 = acc[ai][bj][m][1];
                    v0[0] *= bflo(gw.x); v0[1] *= bfhi(gw.x); v0[2] *= bflo(gw.y); v0[3] *= bfhi(gw.y);
                    v1[0] *= bflo(gw.z); v1[1] *= bfhi(gw.z); v1[2] *= bflo(gw.w); v1[3] *= bfhi(gw.w);
                    float* mp = MF + row * DM + col;
                    if (BR > 0) { v0 += *(const f32x4*)mp; v1 += *(const f32x4*)(mp + 4); }
                    if (BR < 3) { *(f32x4*)mp = v0; *(f32x4*)(mp + 4) = v1; }
                    else { u32x4 w; w.x = pk2(v0[0], v0[1]); w.y = pk2(v0[2], v0[3]); w.z = pk2(v1[0], v1[1]); w.w = pk2(v1[2], v1[3]); *(u32x4*)(MB + row * DM + col) = w; }
                    asm volatile("" ::: "memory"); } }
    }
};
struct EpiF32 {
    static constexpr bool PERM = false;
    float* C; int ldc;
    DI void operator()(const f32x4 (&acc)[2][2][4][2], const pg8::Unit& u, int wr, int wc, int fr, int fq) const {
        asm volatile("" : "+v"(fr), "+v"(fq));
        const int row0 = u.pm * 256 + wr * 64 + fr, col0 = u.pn * 256 + wc * 32 + 4 * fq;
#pragma unroll
        for (int ai = 0; ai < 2; ++ai)
#pragma unroll
            for (int m = 0; m < 4; ++m) { float* rowp = C + (size_t)(row0 + ai * 128 + m * 16) * ldc + col0;
#pragma unroll
                for (int bj = 0; bj < 2; ++bj)
#pragma unroll
                    for (int n = 0; n < 2; ++n) *(f32x4*)(rowp + bj * 128 + n * 16) = acc[ai][bj][m][n]; }
    }
};
struct EpiSwiglu {
    static constexpr bool PERM = true;
    bf16_t* ACT;
    DI void operator()(const f32x4 (&acc)[2][2][4][2], const pg8::Unit& u, int wr, int wc, int fr, int fq) const {
        asm volatile("" : "+v"(fr), "+v"(fq));
        const int row0 = u.pm * 256 + wr * 64 + fr, col0 = u.pn * 128 + wc * 32 + 8 * fq;
#pragma unroll
        for (int ai = 0; ai < 2; ++ai)
#pragma unroll
            for (int m = 0; m < 4; ++m) { bf16_t* rowp = ACT + (size_t)(row0 + ai * 128 + m * 16) * DFF + col0;
                float r[8];
#pragma unroll
                for (int n = 0; n < 2; ++n)
#pragma unroll
                    for (int j = 0; j < 4; ++j) { const float gt = acc[ai][0][m][n][j], up = acc[ai][1][m][n][j]; r[n * 4 + j] = gt * sigmoidf_(gt) * up; }
                u32x4 w; w.x = pk2(r[0], r[1]); w.y = pk2(r[2], r[3]); w.z = pk2(r[4], r[5]); w.w = pk2(r[6], r[7]);
                *(u32x4*)rowp = w; }
    }
};

#define XB_TMO      128
#define XB_XCNT(j)  (256  + 64 * (j))
#define XB_XSUB(j)  (1280 + 64 * (j))
#define XB_XGEN(j)  (2304 + 64 * (j))
#define XB_TOP      3328
#define XB_TOPGEN   3392
#define XCD_BAR_WORDS 3456
#define XB_SPIN_CAP (1u << 18)
__device__ __forceinline__ unsigned xb_ld(unsigned* p)              { return __hip_atomic_load(p, __ATOMIC_RELAXED, __HIP_MEMORY_SCOPE_AGENT); }
__device__ __forceinline__ unsigned xb_add(unsigned* p, unsigned v) { return __hip_atomic_fetch_add(p, v, __ATOMIC_RELAXED, __HIP_MEMORY_SCOPE_AGENT); }
__device__ __forceinline__ unsigned xb_xcc_id() { return (unsigned)__builtin_amdgcn_s_getreg((3 << 11) | 20) & 0xFu; }
#define XB_SPIN(cond, bar) do { unsigned _sp = 0; while (cond) { __builtin_amdgcn_s_sleep(1); \
    if ((++_sp & 255u) == 0u) { if (xb_ld(&(bar)[XB_TMO])) break; if (_sp > XB_SPIN_CAP) { atomicAdd(&(bar)[XB_TMO], 1u); break; } } } } while (0)
struct XcdBarrier { unsigned* bar; unsigned x; volatile LAS unsigned* st; };
__device__ __forceinline__ XcdBarrier xcd_barrier_post(unsigned* bar, volatile LAS unsigned* st) {
    XcdBarrier b; b.bar = bar; b.x = xb_xcc_id(); b.st = st;
    if (threadIdx.x == 0) (void)xb_add(&bar[XB_XCNT(b.x)], 1u);
    return b;
}
__device__ __forceinline__ void xcd_barrier_complete(unsigned* bar, unsigned x, unsigned& nloc, unsigned& nx) {
    const unsigned G = gridDim.x * gridDim.y * gridDim.z;
    unsigned sum, cnt, mine, sp = 0u;
    for (;;) {
        sum = 0u; cnt = 0u; mine = 0u;
#pragma unroll
        for (unsigned j = 0; j < 16; ++j) { const unsigned c = xb_ld(&bar[XB_XCNT(j)]); sum += c; cnt += (c > 0u) ? 1u : 0u; mine = (j == x) ? c : mine; }
        if (sum == G) break;
        __builtin_amdgcn_s_sleep(1);
        if ((++sp & 255u) == 0u) { if (xb_ld(&bar[XB_TMO])) break; if (sp > XB_SPIN_CAP) { atomicAdd(&bar[XB_TMO], 1u); break; } }
    }
    nloc = mine > 0u ? mine : 1u; nx = cnt > 0u ? cnt : 1u;
}
__device__ __forceinline__ void xcd_barrier(const XcdBarrier& b) {
    asm volatile("s_waitcnt vmcnt(0)" ::: "memory");
    __syncthreads();
    if (threadIdx.x == 0) {
        unsigned* bar = b.bar;
        __builtin_amdgcn_s_waitcnt(0);
        unsigned nloc = b.st[0], nx = b.st[1];
        if (nloc == 0u) { xcd_barrier_complete(bar, b.x, nloc, nx); b.st[0] = nloc; b.st[1] = nx; }
        const unsigned old = xb_add(&bar[XB_XSUB(b.x)], 1u);
        const unsigned gen = old / nloc;
        if (old + 1u == (gen + 1u) * nloc) {
            __builtin_amdgcn_fence(__ATOMIC_RELEASE, "agent");
            asm volatile("s_waitcnt vmcnt(0)" ::: "memory");
            const unsigned og = xb_add(&bar[XB_TOP], 1u);
            const unsigned tg = og / nx;
            if (og + 1u == (tg + 1u) * nx) xb_add(&bar[XB_TOPGEN], 1u);
            else XB_SPIN(xb_ld(&bar[XB_TOPGEN]) == tg, bar);
            __builtin_amdgcn_fence(__ATOMIC_ACQUIRE, "agent");
            xb_add(&bar[XB_XGEN(b.x)], 1u);
            asm volatile("s_waitcnt vmcnt(0)" ::: "memory");
        } else {
            XB_SPIN(xb_ld(&bar[XB_XGEN(b.x)]) == gen, bar);
            __builtin_amdgcn_fence(__ATOMIC_ACQUIRE, "agent");
            asm volatile("s_waitcnt vmcnt(0)" ::: "memory");
        }
    }
    __syncthreads();
}

DI size_t launder_off(size_t o) { asm volatile("" : "+s"(o)); return o; }
#define GAS __attribute__((address_space(1)))
#define CAS __attribute__((address_space(4)))
template <class T> DI T* karg_ptr(size_t off) { const CAS char* ka = (const CAS char*)__builtin_amdgcn_kernarg_segment_ptr(); return (T*)(*(GAS T* const CAS*)(ka + launder_off(off))); }
struct Args {
    const float* x; const float* w_in; const float* w_br[4]; const float* w_out;
    const float* lq1; const float* lk1; const float* lq2; const float* lk2; const float* subln; const float* relb;
    const float* w_f1; const float* w_f2; const float* g_pre_mix; const float* g_post_mix; const float* g_pre_ffn; const float* g_post_ffn;
    float* out; unsigned char* ws; int ph_lo, ph_hi;
};

template <class Map>
DI void conv_item(const float* W, int Nsrc, int K, bf16_t* WT, LAS float* scr, int kb, int nb, int lane, Map map) {
    const int k0 = 64 * kb, n0 = 32 * nb;
    int src; float sc; map(n0 + (lane & 31), src, sc);
#pragma unroll 8
    for (int i = 0; i < 32; ++i) { const int kk = 2 * i + (lane >> 5); scr[kk * 33 + (lane & 31)] = (src >= 0) ? W[(size_t)(k0 + kk) * Nsrc + src] * sc : 0.f; }
    asm volatile("s_waitcnt lgkmcnt(0)" ::: "memory");
    const int c = lane & 7;
#pragma unroll
    for (int j = 0; j < 4; ++j) { const int n = (lane >> 3) + 8 * j; const LAS float* s = scr + (8 * c) * 33 + n;
        u32x4 o; o.x = pk2(s[0 * 33], s[1 * 33]); o.y = pk2(s[2 * 33], s[3 * 33]); o.z = pk2(s[4 * 33], s[5 * 33]); o.w = pk2(s[6 * 33], s[7 * 33]);
        *(u32x4*)(WT + (size_t)(n0 + n) * K + k0 + 8 * c) = o; }
    asm volatile("s_waitcnt lgkmcnt(0)" ::: "memory");
}
struct MapIn {
    DI void operator()(int n, int& src, float& sc) const {
        const float QS = 0.125f * LOG2E;
        sc = 1.f;
        if (n < 768) { src = n; if (n < 256) sc = QS; }
        else if (n < 1024) { const int h = (n - 768) >> 6, j = (n - 768) & 63; src = j < 32 ? 768 + 32 * h + j : 896 + 32 * h + (j - 32); sc = 0.17677669529663687f * LOG2E; }
        else if (n < 1280) { const int h = (n - 1024) >> 6, j = (n - 1024) & 63; src = j < 32 ? 1024 + 32 * h + j : 1152 + 32 * h + (j - 32); }
        else if (n < 2304) { src = n; if (n >= 1536 && n < 1792) sc = QS; }
        else if (n < 3072) { src = n - 2304 + 2888; if (n < 2560) sc = QS; }
        else if (n < 3584) { src = n - 3072 + 2304; }
        else if (n < 3648) { src = n - 3584 + 2816; }
        else if (n < 3656) { src = n - 3648 + 2880; sc = 0.35355339059327373f * 0.125f; }
        else if (n < 3840) { src = -1; }
        else { src = n - 3840 + 3656; }
    }
};
struct MapId { DI void operator()(int n, int& src, float& sc) const { src = n; sc = 1.f; } };
struct MapF1 { DI void operator()(int n, int& src, float& sc) const { const int pn = n >> 8, j = n & 255; src = j < 128 ? 128 * pn + j : DFF + 128 * pn + (j - 128); sc = 1.f; } };

DI void norm_row(const float* xin, const float* y, const float* gpost, float* xout, const float* gnext, bf16_t* hout, int lane) {
    f32x4 xv[4];
#pragma unroll
    for (int j = 0; j < 4; ++j) xv[j] = *((const f32x4*)xin + lane + 64 * j);
    if (y) {
        f32x4 yv[4]; float s = 0.f;
#pragma unroll
        for (int j = 0; j < 4; ++j) { yv[j] = *((const f32x4*)y + lane + 64 * j); s += (yv[j][0] * yv[j][0] + yv[j][1] * yv[j][1]) + (yv[j][2] * yv[j][2] + yv[j][3] * yv[j][3]); }
        const float r = 1.0f / sqrtf(wave_sum(s) * (1.f / DM) + EPS);
#pragma unroll
        for (int j = 0; j < 4; ++j) { const f32x4 g = *((const f32x4*)gpost + lane + 64 * j); xv[j] = xv[j] + yv[j] * r * g; *((f32x4*)xout + lane + 64 * j) = xv[j]; }
    }
    if (gnext) {
        float s = 0.f;
#pragma unroll
        for (int j = 0; j < 4; ++j) s += (xv[j][0] * xv[j][0] + xv[j][1] * xv[j][1]) + (xv[j][2] * xv[j][2] + xv[j][3] * xv[j][3]);
        const float r = 1.0f / sqrtf(wave_sum(s) * (1.f / DM) + EPS);
#pragma unroll
        for (int j = 0; j < 4; ++j) { const f32x4 g = *((const f32x4*)gnext + lane + 64 * j); const f32x4 h = xv[j] * r * g;
            u32x2 w; w.x = pk2(h[0], h[1]); w.y = pk2(h[2], h[3]); *((u32x2*)hout + lane + 64 * j) = w; }
    }
}

#define MFMA32(a, b, c) __builtin_amdgcn_mfma_f32_32x32x16_bf16((a), (b), (c), 0, 0, 0)
#define MFMA16(a, b, c) __builtin_amdgcn_mfma_f32_16x16x32_bf16((a), (b), (c), 0, 0, 0)
struct Geo { int tid, lane, wid, r32, hi; };
DI Geo make_geo() { int t = threadIdx.x; asm volatile("" : "+v"(t)); Geo g; g.tid = t; g.lane = t & 63; g.wid = __builtin_amdgcn_readfirstlane(t >> 6); g.r32 = t & 31; g.hi = (t >> 5) & 1; return g; }
DI int crow(int i) { return (i & 3) + 8 * (i >> 2); }
constexpr float NEG_INF = -__builtin_inff();

DI void kv_stage(const bf16_t* Kg, const bf16_t* Vg, int key0, const Geo& g, LAS unsigned char* kb, LAS unsigned char* vb) {
    __builtin_amdgcn_global_load_lds((const unsigned*)(Kg + (size_t)(key0 + g.lane) * NZQ + g.wid * 8), (LAS unsigned*)(kb + g.wid * 1024), 16, 0, 0);
    __builtin_amdgcn_global_load_lds((const unsigned*)(Vg + (size_t)(key0 + 16 * (g.wid & 3) + (g.lane >> 2)) * NZQ + (g.wid >> 2) * 32 + (g.lane & 3) * 8), (LAS unsigned*)(vb + g.wid * 1024), 16, 0, 0);
}
template <int D0A, int D0B>
DI void qk_tile(const LAS unsigned char* kb, const bf16x8 (&qf)[4], const Geo& g, f32x16& s0, f32x16& s1) {
#pragma unroll
    for (int d0 = D0A; d0 < D0B; ++d0) {
        const bf16x8 k0 = *(const LAS bf16x8*)(kb + (2 * d0 + g.hi) * 1024 + g.r32 * 16);
        const bf16x8 k1 = *(const LAS bf16x8*)(kb + (2 * d0 + g.hi) * 1024 + 512 + g.r32 * 16);
        s0 = MFMA32(k0, qf[d0], s0); s1 = MFMA32(k1, qf[d0], s1);
    }
}
DI bf16x8 pack8(const f32x16& p, int s) {
    u32x4 w;
    if (s == 0) { w.x = pk2(p[0], p[1]); w.y = pk2(p[2], p[3]); w.z = pk2(p[4], p[5]); w.w = pk2(p[6], p[7]); }
    else { w.x = pk2(p[8], p[9]); w.y = pk2(p[10], p[11]); w.z = pk2(p[12], p[13]); w.w = pk2(p[14], p[15]); }
    return __builtin_bit_cast(bf16x8, w);
}
DI s16x4 vtr(const LAS unsigned char* p) { return __builtin_bit_cast(s16x4, __builtin_amdgcn_ds_read_tr16_b64_v4i16((LAS s16x4*)p)); }
DI void pv_tile(const LAS unsigned char* vb, const Geo& g, const f32x16& p0, const f32x16& p1, f32x16& o0, f32x16& o1) {
    const LAS unsigned char* vp = vb + ((g.lane >> 4) & 1) * 32 + (g.lane & 3) * 8 + (4 * g.hi + ((g.lane & 15) >> 2)) * 64;
#pragma unroll
    for (int ks = 0; ks < 4; ++ks) {
        const bf16x8 pf = pack8((ks & 2) ? p1 : p0, ks & 1);
        { const s16x4 lo = vtr(vp + ks * 1024), hh = vtr(vp + ks * 1024 + 512); const bf16x8 vf = __builtin_shufflevector(lo, hh, 0, 1, 2, 3, 4, 5, 6, 7); o0 = MFMA32(vf, pf, o0); }
        { const s16x4 lo = vtr(vp + 4096 + ks * 1024), hh = vtr(vp + 4096 + ks * 1024 + 512); const bf16x8 vf = __builtin_shufflevector(lo, hh, 0, 1, 2, 3, 4, 5, 6, 7); o1 = MFMA32(vf, pf, o1); }
    }
}
DI void softmax_step(f32x16& s0, f32x16& s1, float& m, float& l, f32x16& o0, f32x16& o1) {
    float mx = NEG_INF;
#pragma unroll
    for (int i = 0; i < 16; ++i) mx = fmaxf(mx, fmaxf(s0[i], s1[i]));
    mx = fmaxf(mx, other_half(mx));
    const float mn = fmaxf(m, mx), alpha = ex2(m - mn);
    float rs = 0.f;
#pragma unroll
    for (int i = 0; i < 16; ++i) { s0[i] = ex2(s0[i] - mn); s1[i] = ex2(s1[i] - mn); rs += s0[i] + s1[i]; }
    l = l * alpha + rs; m = mn;
#pragma unroll
    for (int i = 0; i < 16; ++i) { o0[i] *= alpha; o1[i] *= alpha; }
}
DI void fill_bias_table(LAS float* tb, const float* relb, int hcol, int tid) {
    if (tid < 128) { const int d = tid; int bk;
        if (d < 16) bk = d; else { const float lr = logf((float)d * (1.0f / 16.0f)) / 2.0794415416798357f; bk = 16 + (int)(lr * 16.0f); bk = bk < 31 ? bk : 31; }
        tb[d] = relb[bk * 12 + hcol] * LOG2E; }
}
template <class V>
DI void bias_mask(f32x16& s0, f32x16& s1, int kt, int qq, int hi, bool far, const LAS float* tb, V valid) {
    const int kb = 64 * kt + 4 * hi;
    if (far) { const float b = tb[127];
#pragma unroll
        for (int i = 0; i < 16; ++i) { const int d0 = qq - (kb + crow(i)), d1 = d0 - 32;
            s0[i] = valid(0, i, d0) ? s0[i] + b : NEG_INF; s1[i] = valid(1, i, d1) ? s1[i] + b : NEG_INF; }
    } else {
#pragma unroll
        for (int i = 0; i < 16; ++i) { const int d0 = qq - (kb + crow(i)), d1 = d0 - 32;
            const int c0 = d0 < 0 ? 0 : (d0 > 127 ? 127 : d0), c1 = d1 < 0 ? 0 : (d1 > 127 ? 127 : d1);
            const float b0 = tb[c0], b1 = tb[c1];
            const float t0 = s0[i] + b0, t1 = s1[i] + b1;
            s0[i] = valid(0, i, d0) ? t0 : NEG_INF; s1[i] = valid(1, i, d1) ? t1 : NEG_INF; }
    }
}
DI void store_o(bf16_t* orow, int hi, const f32x16& o0, const f32x16& o1) {
#pragma unroll
    for (int g4 = 0; g4 < 4; ++g4) {
        u32x2 w0; w0.x = pk2(o0[4 * g4], o0[4 * g4 + 1]); w0.y = pk2(o0[4 * g4 + 2], o0[4 * g4 + 3]); *(u32x2*)(orow + 8 * g4 + 4 * hi) = w0;
        u32x2 w1; w1.x = pk2(o1[4 * g4], o1[4 * g4 + 1]); w1.y = pk2(o1[4 * g4 + 2], o1[4 * g4 + 3]); *(u32x2*)(orow + 32 + 8 * g4 + 4 * hi) = w1;
    }
}
DI void load_q(bf16x8 (&qf)[4], const bf16_t* qrow, int hi) {
#pragma unroll
    for (int d0 = 0; d0 < 4; ++d0) qf[d0] = *(const bf16x8*)(qrow + 16 * d0 + 8 * hi);
}
constexpr int AT_TB = 32768, AT_KM = 32768 + 512;

template <bool REV, class F>
DI void kv_loop(const bf16_t* Kg, const bf16_t* Vg, int NT, LAS unsigned char* lds, const Geo& g, F&& tile) {
    kv_stage(Kg, Vg, 64 * (REV ? NT - 1 : 0), g, lds, lds + 8192);
    asm volatile("s_waitcnt vmcnt(0)" ::: "memory"); __syncthreads();
    for (int it = 0; it < NT; ++it) {
        const int kt = REV ? NT - 1 - it : it; const int buf = it & 1;
        if (it + 1 < NT) kv_stage(Kg, Vg, 64 * (REV ? kt - 1 : kt + 1), g, lds + (buf ^ 1) * 16384, lds + (buf ^ 1) * 16384 + 8192);
        tile(kt, (const LAS unsigned char*)(lds + buf * 16384), (const LAS unsigned char*)(lds + buf * 16384 + 8192));
        asm volatile("s_waitcnt vmcnt(0)" ::: "memory"); __syncthreads();
    }
}

DI void sb_unit(const bf16_t* z, bf16_t* o, LAS unsigned char* lds, int b, int h, int qt) {
    const Geo g = make_geo();
    const size_t rb = (size_t)b * SEQ;
    const bf16_t* Kg = z + rb * NZQ + ZC_KSB + 64 * h; const bf16_t* Vg = z + rb * NZQ + ZC_VSB + 64 * h;
    const int q0w = 256 * qt + 32 * g.wid, qq = q0w + g.r32;
    bf16x8 qf[4]; load_q(qf, z + (rb + qq) * NZQ + ZC_QSB + 64 * h, g.hi);
    const int NT = 4 * qt + 4;
    f32x16 o0 = {}, o1 = {}; float R = 0.f;
    kv_loop<true>(Kg, Vg, NT, lds, g, [&](int kt, const LAS unsigned char* kb, const LAS unsigned char* vb) {
        if (64 * kt < q0w + 31) {
            f32x16 s0 = {}, s1 = {};
            qk_tile<0, 4>(kb, qf, g, s0, s1);
            const int kbase = 64 * kt + 4 * g.hi;
            f32x16 sp0, sp1;
#pragma unroll
            for (int i = 0; i < 16; ++i) {
                const bool v0 = (kbase + crow(i)) < qq, v1 = (kbase + 32 + crow(i)) < qq;
                const float z0 = s0[i], z1 = s1[i];
                const float a0 = fmaxf(z0, 0.f) + lg2(1.0f + ex2(-fabsf(z0))), a1 = fmaxf(z1, 0.f) + lg2(1.0f + ex2(-fabsf(z1)));
                sp0[i] = v0 ? a0 : 0.f; sp1[i] = v1 ? a1 : 0.f;
            }
            float gs[8], og[8];
#pragma unroll
            for (int q4 = 0; q4 < 4; ++q4) { gs[q4] = (sp0[4 * q4] + sp0[4 * q4 + 1]) + (sp0[4 * q4 + 2] + sp0[4 * q4 + 3]); gs[4 + q4] = (sp1[4 * q4] + sp1[4 * q4 + 1]) + (sp1[4 * q4 + 2] + sp1[4 * q4 + 3]); }
#pragma unroll
            for (int j = 0; j < 8; ++j) og[j] = other_half(gs[j]);
            float sg[8]; float run = 0.f;
#pragma unroll
            for (int j = 7; j >= 0; --j) {
                const float a1v = g.hi ? gs[j] : og[j], a0v = g.hi ? og[j] : gs[j];
                const float sg1 = run; run += a1v; const float sg0 = run; run += a0v;
                sg[j] = g.hi ? sg1 : sg0;
            }
#pragma unroll
            for (int q4 = 0; q4 < 4; ++q4) {
                {   const float t3 = R + sg[q4], t2 = t3 + sp0[4 * q4 + 3], t1 = t2 + sp0[4 * q4 + 2], t0 = t1 + sp0[4 * q4 + 1];
                    const float tt[4] = {t0, t1, t2, t3};
#pragma unroll
                    for (int e = 0; e < 4; ++e) { const int i = 4 * q4 + e; const bool v = (kbase + crow(i)) < qq; s0[i] = v ? ex2(s0[i] - sp0[i] - tt[e]) : 0.f; } }
                {   const float t3 = R + sg[4 + q4], t2 = t3 + sp1[4 * q4 + 3], t1 = t2 + sp1[4 * q4 + 2], t0 = t1 + sp1[4 * q4 + 1];
                    const float tt[4] = {t0, t1, t2, t3};
#pragma unroll
                    for (int e = 0; e < 4; ++e) { const int i = 4 * q4 + e; const bool v = (kbase + 32 + crow(i)) < qq; s1[i] = v ? ex2(s1[i] - sp1[i] - tt[e]) : 0.f; } }
            }
            R += run;
            pv_tile(vb, g, s0, s1, o0, o1);
        }
    });
    store_o(o + (rb + qq) * DM + OC_SB + 64 * h, g.hi, o0, o1);
}

DI void diff_unit(const float* relb, const float* lq1, const float* lk1, const float* lq2, const float* lk2, const float* subln, const bf16_t* z, bf16_t* o, LAS unsigned char* lds, int layer, int b, int h, int qt) {
    const Geo g = make_geo();
    const size_t rb = (size_t)b * SEQ;
    const bf16_t* Kg = z + rb * NZQ + ZC_KD + 64 * h; const bf16_t* Vg = z + rb * NZQ + ZC_VD + 64 * h;
    const int q0w = 256 * qt + 32 * g.wid, qq = q0w + g.r32;
    LAS float* tb = (LAS float*)(lds + AT_TB);
    fill_bias_table(tb, relb, h, g.tid);
    const int li = layer * 32 + g.r32;
    const float d1 = wave_sum(g.hi ? 0.f : lq1[li] * lk1[li]), d2 = wave_sum(g.hi ? 0.f : lq2[li] * lk2[li]);
    const float lam_init = 0.8f - 0.6f * expf(-0.3f * (float)layer);
    const float lam = expf(d1) - expf(d2) + lam_init;
    bf16x8 qf[4]; load_q(qf, z + (rb + qq) * NZQ + ZC_QD + 64 * h, g.hi);
    const int NT = 4 * qt + 4;
    f32x16 oa0 = {}, oa1 = {}, ob0 = {}, ob1 = {}; float m1 = -1e30f, l1 = 0.f, m2 = -1e30f, l2 = 0.f;
    kv_loop<false>(Kg, Vg, NT, lds, g, [&](int kt, const LAS unsigned char* kb, const LAS unsigned char* vb) {
        if (64 * kt <= q0w + 31) {
            const bool far = (q0w - (64 * kt + 63)) >= 127;
            auto valid = [&](int, int, int dist) { return dist >= 0; };
            {   f32x16 s0 = {}, s1 = {};
                qk_tile<0, 2>(kb, qf, g, s0, s1);
                bias_mask(s0, s1, kt, qq, g.hi, far, tb, valid);
                softmax_step(s0, s1, m1, l1, oa0, oa1);
                pv_tile(vb, g, s0, s1, oa0, oa1); }
            __builtin_amdgcn_sched_barrier(0);
            {   f32x16 s0 = {}, s1 = {};
                qk_tile<2, 4>(kb, qf, g, s0, s1);
                bias_mask(s0, s1, kt, qq, g.hi, far, tb, valid);
                softmax_step(s0, s1, m2, l2, ob0, ob1);
                pv_tile(vb, g, s0, s1, ob0, ob1); }
        }
    });
    l1 += other_half(l1); l2 += other_half(l2);
    const float i1 = 1.0f / l1, i2 = lam / l2;
    float ss = 0.f;
#pragma unroll
    for (int i = 0; i < 16; ++i) { oa0[i] = oa0[i] * i1 - ob0[i] * i2; oa1[i] = oa1[i] * i1 - ob1[i] * i2; ss += oa0[i] * oa0[i] + oa1[i] * oa1[i]; }
    ss += other_half(ss);
    const float r = (1.0f - lam_init) / sqrtf(ss * (1.f / 64.f) + EPS);
    const float* sg = subln + launder_off((size_t)layer * 64);
#pragma unroll
    for (int i = 0; i < 16; ++i) { const int d = crow(i) + 4 * g.hi; oa0[i] *= r * sg[d]; oa1[i] *= r * sg[32 + d]; }
    store_o(o + (rb + qq) * DM + OC_DF + 64 * h, g.hi, oa0, oa1);
}

DI void dsa_unit(const float* relb, const bf16_t* z, const unsigned long long* mask, bf16_t* o, LAS unsigned char* lds, int b, int h, int qt) {
    const Geo g = make_geo();
    const size_t rb = (size_t)b * SEQ;
    const bf16_t* Kg = z + rb * NZQ + ZC_KDS + 64 * h; const bf16_t* Vg = z + rb * NZQ + ZC_VDS + 64 * h;
    const int q0w = 256 * qt + 32 * g.wid, qq = q0w + g.r32;
    LAS float* tb = (LAS float*)(lds + AT_TB);
    fill_bias_table(tb, relb, 4 + h, g.tid);
    bf16x8 qf[4]; load_q(qf, z + (rb + qq) * NZQ + ZC_QDS + 64 * h, g.hi);
    const unsigned long long* mrow = mask + (rb + qq) * 32;
    const int NT = 4 * qt + 4;
    f32x16 o0 = {}, o1 = {}; float m = -1e30f, l = 0.f;
    kv_loop<false>(Kg, Vg, NT, lds, g, [&](int kt, const LAS unsigned char* kb, const LAS unsigned char* vb) {
        if (64 * kt <= q0w + 31) {
            const bool far = (q0w - (64 * kt + 63)) >= 127;
            unsigned long long mw = mrow[kt]; mw >>= (4 * g.hi);
            const unsigned mlo = (unsigned)mw, mhi = (unsigned)(mw >> 32);
            auto valid = [&](int n, int i, int) { return (((n ? mhi : mlo) >> crow(i)) & 1u) != 0u; };
            f32x16 s0 = {}, s1 = {};
            qk_tile<0, 4>(kb, qf, g, s0, s1);
            bias_mask(s0, s1, kt, qq, g.hi, far, tb, valid);
            softmax_step(s0, s1, m, l, o0, o1);
            pv_tile(vb, g, s0, s1, o0, o1);
        }
    });
    l += other_half(l);
    const float il = 1.0f / l;
#pragma unroll
    for (int i = 0; i < 16; ++i) { o0[i] *= il; o1[i] *= il; }
    store_o(o + (rb + qq) * DM + OC_DS + 64 * h, g.hi, o0, o1);
}

DI void moba_unit(const float* relb, const bf16_t* z, const float* kmean, bf16_t* o, LAS unsigned char* lds, int b, int h, int qt) {
    const Geo g = make_geo();
    const size_t rb = (size_t)b * SEQ;
    const bf16_t* Kg = z + rb * NZQ + ZC_KMB + 64 * h; const bf16_t* Vg = z + rb * NZQ + ZC_VMB + 64 * h;
    const int q0w = 256 * qt + 32 * g.wid, qq = q0w + g.r32;
    LAS float* tb = (LAS float*)(lds + AT_TB); LAS float* km = (LAS float*)(lds + AT_KM);
    fill_bias_table(tb, relb, 8 + h, g.tid);
    { const int n = g.tid >> 6, d = g.tid & 63; km[g.tid] = kmean[((size_t)b * 8 + n) * 256 + 64 * h + d]; }
    bf16x8 qf[4]; load_q(qf, z + (rb + qq) * NZQ + ZC_QMB + 64 * h, g.hi);
    __syncthreads();
    const int own = qt;
    float gate[8];
#pragma unroll
    for (int n = 0; n < 7; ++n) { float p = 0.f;
        if (n < own) {
#pragma unroll
            for (int d0 = 0; d0 < 4; ++d0)
#pragma unroll
                for (int j = 0; j < 8; ++j) p += bf2f((unsigned short)qf[d0][j]) * km[n * 64 + 16 * d0 + 8 * g.hi + j];
            p += other_half(p); }
        gate[n] = p; }
    unsigned sel = 0u;
#pragma unroll
    for (int n = 0; n < 7; ++n) if (n < own) { int rank = 0;
#pragma unroll
        for (int n2 = 0; n2 < 7; ++n2) if (n2 < own && n2 != n) rank += (gate[n2] > gate[n] || (gate[n2] == gate[n] && n2 < n)) ? 1 : 0;
        if (rank < 3) sel |= 1u << n; }
    const int NT = 4 * qt + 4;
    f32x16 o0 = {}, o1 = {}; float m = -1e30f, l = 0.f;
    kv_loop<false>(Kg, Vg, NT, lds, g, [&](int kt, const LAS unsigned char* kb, const LAS unsigned char* vb) {
        if (64 * kt <= q0w + 31) {
            const bool far = (q0w - (64 * kt + 63)) >= 127;
            const int blk = kt >> 2; const bool past = blk < own; const bool rowsel = ((sel >> blk) & 1u) != 0u;
            auto valid = [&](int, int, int dist) { return past ? rowsel : dist >= 0; };
            f32x16 s0 = {}, s1 = {};
            qk_tile<0, 4>(kb, qf, g, s0, s1);
            bias_mask(s0, s1, kt, qq, g.hi, far, tb, valid);
            softmax_step(s0, s1, m, l, o0, o1);
            pv_tile(vb, g, s0, s1, o0, o1);
        }
    });
    l += other_half(l);
    const float il = 1.0f / l;
#pragma unroll
    for (int i = 0; i < 16; ++i) { o0[i] *= il; o1[i] *= il; }
    store_o(o + (rb + qq) * DM + OC_MB + 64 * h, g.hi, o0, o1);
}

constexpr int SC_LD = 2052;
DI unsigned okey(float x) { const unsigned u = __float_as_uint(x); return (u & 0x80000000u) ? ~u : (u | 0x80000000u); }
DI void idx_unit(const bf16_t* z, unsigned long long* mask, LAS unsigned char* lds, int b, int qb) {
    const Geo g = make_geo();
    const size_t rb = (size_t)b * SEQ; const int q0 = 16 * qb;
    const int c = g.lane & 15, gq = g.lane >> 4;
    LAS float* sc = (LAS float*)lds;
    const int ntile = (q0 + 15) / 64 + 1;
    {
        bf16x8 qf[8][2]; float wv[8];
        const bf16_t* qrow = z + (rb + q0 + c) * NZQ;
#pragma unroll
        for (int h8 = 0; h8 < 8; ++h8) {
            qf[h8][0] = *(const bf16x8*)(qrow + ZC_QI + 64 * h8 + 8 * gq); qf[h8][1] = *(const bf16x8*)(qrow + ZC_QI + 64 * h8 + 32 + 8 * gq);
            wv[h8] = bf2f(qrow[ZC_WI + h8]); }
        for (int kt = g.wid; kt < ntile; kt += 8) {
#pragma unroll
            for (int kb4 = 0; kb4 < 4; ++kb4) {
                const int key0 = 64 * kt + 16 * kb4;
                const bf16_t* krow = z + (rb + key0 + c) * NZQ + ZC_KI;
                const bf16x8 k0 = *(const bf16x8*)(krow + 8 * gq), k1 = *(const bf16x8*)(krow + 32 + 8 * gq);
                f32x4 s = {0.f, 0.f, 0.f, 0.f};
#pragma unroll
                for (int h8 = 0; h8 < 8; ++h8) {
                    f32x4 a = {0.f, 0.f, 0.f, 0.f};
                    a = MFMA16(k0, qf[h8][0], a); a = MFMA16(k1, qf[h8][1], a);
#pragma unroll
                    for (int i = 0; i < 4; ++i) s[i] += wv[h8] * fmaxf(a[i], 0.f);
                }
                *(LAS f32x4*)(sc + c * SC_LD + key0 + 4 * gq) = s;
            }
        }
    }
    __syncthreads();
#define SB0() __builtin_amdgcn_sched_barrier(0)
#pragma unroll 1
    for (int rr = 0; rr < 2; ++rr) {
        const int row = 2 * g.wid + rr, q = q0 + row, n = q + 1;
        unsigned kk[32];
#pragma unroll
        for (int j = 0; j < 32; ++j) { const int key = 64 * j + g.lane; kk[j] = key < n ? okey(sc[row * SC_LD + key]) : 0u; }
        unsigned thr = 1u;
        int need = 0;
        bool ties = false;
        if (n > 256) {
            unsigned prefix = 0u; bool exact = false;
#pragma unroll 1
            for (int bit = 31; bit >= 0; --bit) {
                const unsigned cand = prefix | (1u << bit); int cnt = 0;
#pragma unroll
                for (int j = 0; j < 32; ++j) { cnt += __popcll(__ballot(kk[j] >= cand)); SB0(); }
                if (cnt >= 256) prefix = cand;
                if (cnt == 256) { exact = true; break; }
            }
            thr = prefix;
            if (!exact) {
                int cgt = 0;
#pragma unroll
                for (int j = 0; j < 32; ++j) { cgt += __popcll(__ballot(kk[j] > prefix)); SB0(); }
                need = 256 - cgt; ties = true;
            }
        }
        unsigned long long myw = 0ull;
#pragma unroll
        for (int j = 0; j < 32; ++j) {
            unsigned long long bl;
            if (!ties) bl = __ballot(kk[j] >= thr);
            else {
                bl = __ballot(kk[j] > thr); unsigned long long eq = __ballot(kk[j] == thr);
                int ce = __popcll(eq);
                while (ce > need) { eq &= ~(1ull << (63 - __clzll(eq))); --ce; }
                need -= ce; bl |= eq;
            }
            if (g.lane == j) myw = bl;
            SB0();
        }
        if (g.lane < 32) mask[(rb + q) * 32 + g.lane] = myw;
    }
#undef SB0
    __syncthreads();
}

DI void kmean_unit(const bf16_t* z, float* kmean, LAS unsigned char* lds, int b, int blk) {
    const Geo g = make_geo();
    const int c = g.tid & 255, half = g.tid >> 8;
    const bf16_t* p = z + ((size_t)b * SEQ + 256 * blk + 128 * half) * NZQ + ZC_KMB + c;
    float s = 0.f;
    for (int r = 0; r < 128; ++r) s += bf2f(p[(size_t)r * NZQ]);
    LAS float* sh = (LAS float*)lds;
    if (half) sh[c] = s;
    __syncthreads();
    if (!half) kmean[((size_t)b * 8 + blk) * 256 + c] = (s + sh[c]) * (1.0f / 256.0f);
    __syncthreads();
}

constexpr int NPH_LAYER = 9, NPH = 1 + NL * NPH_LAYER;
__global__ void __launch_bounds__(512, 2) trunk_fwd(Args A) {
#define KF(field) karg_ptr<const float>(offsetof(Args, field))
    extern __shared__ __attribute__((aligned(16))) unsigned char lds_raw[];
    LAS unsigned char* lds = (LAS unsigned char*)lds_raw;
    const int G = gridDim.x, bx = blockIdx.x;
#define ctl ((unsigned*)(karg_ptr<unsigned char>(offsetof(Args, ws)) + launder_off(WS_CTL)))
#define Wt_in ((bf16_t*)(karg_ptr<unsigned char>(offsetof(Args, ws)) + launder_off(WS_WIN)))
#define Wt_br ((bf16_t*)(karg_ptr<unsigned char>(offsetof(Args, ws)) + launder_off(WS_WBR)))
#define Wt_out ((bf16_t*)(karg_ptr<unsigned char>(offsetof(Args, ws)) + launder_off(WS_WOUT)))
#define Wt_f1 ((bf16_t*)(karg_ptr<unsigned char>(offsetof(Args, ws)) + launder_off(WS_WF1)))
#define Wt_f2 ((bf16_t*)(karg_ptr<unsigned char>(offsetof(Args, ws)) + launder_off(WS_WF2)))
#define hbuf ((bf16_t*)(karg_ptr<unsigned char>(offsetof(Args, ws)) + launder_off(WS_H)))
#define z ((bf16_t*)(karg_ptr<unsigned char>(offsetof(Args, ws)) + launder_off(WS_ZQ)))
#define zg ((bf16_t*)(karg_ptr<unsigned char>(offsetof(Args, ws)) + launder_off(WS_ZG)))
#define obuf ((bf16_t*)(karg_ptr<unsigned char>(offsetof(Args, ws)) + launder_off(WS_O)))
#define mask ((unsigned long long*)(karg_ptr<unsigned char>(offsetof(Args, ws)) + launder_off(WS_MASK)))
#define kmean ((float*)(karg_ptr<unsigned char>(offsetof(Args, ws)) + launder_off(WS_KMEAN)))
#define mf ((float*)(karg_ptr<unsigned char>(offsetof(Args, ws)) + launder_off(WS_MF)))
#define mb ((bf16_t*)(karg_ptr<unsigned char>(offsetof(Args, ws)) + launder_off(WS_MB)))
#define y1 ((float*)(karg_ptr<unsigned char>(offsetof(Args, ws)) + launder_off(WS_Y1)))
#define y2 ((float*)(karg_ptr<unsigned char>(offsetof(Args, ws)) + launder_off(WS_Y2)))
#define act ((bf16_t*)(karg_ptr<unsigned char>(offsetof(Args, ws)) + launder_off(WS_ACT)))
    if (threadIdx.x < 64) ((LAS unsigned*)(lds + LDS_CTL))[threadIdx.x] = 0u;
    __syncthreads();
#if MK_ONE_LAUNCH
    XcdBarrier bar = xcd_barrier_post(ctl + CW_BAR, (volatile LAS unsigned*)(lds + LDS_CTL));
#define GRID_BAR() xcd_barrier(bar)
#else
#define GRID_BAR() do { } while (0)
#endif
    const int lo = A.ph_lo, hi = A.ph_hi;
#define IN(k) (lo <= (k) && (k) < hi)
#define SEAM(k) do { if (IN((k) + 1)) GRID_BAR(); } while (0)

    if (PHEN(0) && IN(0)) {
        const Geo g = make_geo();
        LAS float* scr = (LAS float*)(lds + g.wid * 16384);
        const int gw = bx * 8 + g.wid, NGW = G * 8;
        constexpr int I_IN = 16 * (NZ / 32), I_BR = 4 * 4 * 32, I_OUT = 16 * 32, I_F1 = 16 * (NF1 / 32), I_F2 = (DFF / 64) * 32;
        constexpr int I_LAYER = I_IN + I_BR + I_OUT + I_F1 + I_F2;
        for (int it = gw; it < NL * I_LAYER; it += NGW) {
            const int l = it / I_LAYER; int r = it % I_LAYER;
            if (r < I_IN) { conv_item(KF(w_in) + (size_t)l * DM * N_IN, N_IN, DM, Wt_in + (size_t)l * NZ * DM, scr, r / (NZ / 32), r % (NZ / 32), g.lane, MapIn()); continue; } r -= I_IN;
            if (r < I_BR) { const int br = r / 128, rr = r % 128; conv_item(karg_ptr<const float>(offsetof(Args, w_br) + 8 * (size_t)br) + (size_t)l * 256 * DM, DM, 256, Wt_br + ((size_t)l * 4 + br) * DM * 256, scr, rr / 32, rr % 32, g.lane, MapId()); continue; } r -= I_BR;
            if (r < I_OUT) { conv_item(KF(w_out) + (size_t)l * DM * DM, DM, DM, Wt_out + (size_t)l * DM * DM, scr, r / 32, r % 32, g.lane, MapId()); continue; } r -= I_OUT;
            if (r < I_F1) { conv_item(KF(w_f1) + (size_t)l * DM * NF1, NF1, DM, Wt_f1 + (size_t)l * NF1 * DM, scr, r / (NF1 / 32), r % (NF1 / 32), g.lane, MapF1()); continue; } r -= I_F1;
            conv_item(KF(w_f2) + (size_t)l * DFF * DM, DM, DFF, Wt_f2 + (size_t)l * DM * DFF, scr, r / 32, r % 32, g.lane, MapId());
        }
        for (int m = gw; m < M; m += NGW) norm_row(KF(x) + (size_t)m * DM, nullptr, nullptr, nullptr, KF(g_pre_mix), hbuf + (size_t)m * DM, g.lane);
        SEAM(0);
    }

    for (int layer = 0; layer < NL; ++layer) {
        const int pb = 1 + layer * NPH_LAYER;
        if (PHEN(1) && IN(pb + 0)) {
            pg8::Gemm gm{hbuf, Wt_in + (size_t)layer * NZ * DM, M, NZ, DM, DM, DM}; pg8::StaticOrder S; S.init(M, NZ, G, bx);
            EpiZ E{z, zg}; pg8::gemm_phase(lds, gm, S, E);
            SEAM(pb + 0);
        }
        if (IN(pb + 1)) {
            const Geo g = make_geo();
            for (int u = bx; u < 7 * 256; u += G) {
                const int k = u >> 8, w = u & 255;
                if (k == 0) { if (PHEN(2)) sb_unit(z, obuf, lds, w >> 5, (w >> 3) & 3, w & 7); }
                else if (k == 1) { if (PHEN(3)) diff_unit(KF(relb), KF(lq1), KF(lk1), KF(lq2), KF(lk2), KF(subln), z, obuf, lds, layer, w >> 5, (w >> 3) & 3, 7 - (w & 7)); }
                else if (k < 6) { const int b = w >> 5, r = w & 31; const int qb = k == 2 ? r : (k == 3 ? 63 - r : (k == 4 ? 64 + r : 127 - r)); if (PHEN(4)) idx_unit(z, mask, lds, b, qb); }
                else if (w < 64) { if (PHEN(5)) kmean_unit(z, kmean, lds, w >> 3, w & 7); }
            }
            SEAM(pb + 1);
        }
        if (IN(pb + 2)) {
            const Geo g = make_geo();
            for (int u = bx; u < 2 * 256; u += G) {
                const int k = u >> 8, w = u & 255;
                if (k == 0) { if (PHEN(6)) dsa_unit(KF(relb), z, mask, obuf, lds, w >> 5, (w >> 3) & 3, w & 7); }
                else { if (PHEN(7)) moba_unit(KF(relb), z, kmean, obuf, lds, w >> 5, (w >> 3) & 3, 7 - (w & 7)); }
            }
            SEAM(pb + 2);
        }
        if (PHEN(8) && IN(pb + 3)) {
            pg8::StaticOrder S; S.init(M, DM, G, bx);
            const bf16_t* wb = Wt_br + (size_t)layer * 4 * DM * 256;
            { pg8::Gemm gm{obuf + 0, wb, M, DM, 256, DM, 256}; EpiBranch<0> E{zg, mf, mb}; pg8::gemm_phase(lds, gm, S, E); }
            asm volatile("s_waitcnt vmcnt(0)" ::: "memory"); __syncthreads();
            { pg8::Gemm gm{obuf + 256, wb + (size_t)DM * 256, M, DM, 256, DM, 256}; EpiBranch<1> E{zg, mf, mb}; pg8::gemm_phase(lds, gm, S, E); }
            asm volatile("s_waitcnt vmcnt(0)" ::: "memory"); __syncthreads();
            { pg8::Gemm gm{obuf + 512, wb + (size_t)2 * DM * 256, M, DM, 256, DM, 256}; EpiBranch<2> E{zg, mf, mb}; pg8::gemm_phase(lds, gm, S, E); }
            asm volatile("s_waitcnt vmcnt(0)" ::: "memory"); __syncthreads();
            { pg8::Gemm gm{obuf + 768, wb + (size_t)3 * DM * 256, M, DM, 256, DM, 256}; EpiBranch<3> E{zg, mf, mb}; pg8::gemm_phase(lds, gm, S, E); }
            SEAM(pb + 3);
        }
        if (PHEN(9) && IN(pb + 4)) {
            pg8::Gemm gm{mb, Wt_out + (size_t)layer * DM * DM, M, DM, DM, DM, DM}; pg8::StaticOrder S; S.init(M, DM, G, bx);
            EpiF32 E{y1, DM}; pg8::gemm_phase(lds, gm, S, E);
            SEAM(pb + 4);
        }
        if (PHEN(10) && IN(pb + 5)) {
            const Geo g = make_geo();
            const int gw = bx * 8 + g.wid, NGW = G * 8;
            const float* xin = layer == 0 ? KF(x) : karg_ptr<float>(offsetof(Args, out));
            for (int m = gw; m < M; m += NGW) norm_row(xin + (size_t)m * DM, y1 + (size_t)m * DM, KF(g_post_mix) + layer * DM, karg_ptr<float>(offsetof(Args, out)) + (size_t)m * DM, KF(g_pre_ffn) + layer * DM, hbuf + (size_t)m * DM, g.lane);
            SEAM(pb + 5);
        }
        if (PHEN(11) && IN(pb + 6)) {
            pg8::Gemm gm{hbuf, Wt_f1 + (size_t)layer * NF1 * DM, M, NF1, DM, DM, DM}; pg8::StaticOrder S; S.init(M, NF1, G, bx);
            EpiSwiglu E{act}; pg8::gemm_phase(lds, gm, S, E);
            SEAM(pb + 6);
        }
        if (PHEN(12) && IN(pb + 7)) {
            pg8::Gemm gm{act, Wt_f2 + (size_t)layer * DM * DFF, M, DM, DFF, DFF, DFF}; pg8::StaticOrder S; S.init(M, DM, G, bx);
            EpiF32 E{y2, DM}; pg8::gemm_phase(lds, gm, S, E);
            SEAM(pb + 7);
        }
        if (PHEN(10) && IN(pb + 8)) {
            const Geo g = make_geo();
            const int gw = bx * 8 + g.wid, NGW = G * 8;
            const float* gn = layer + 1 < NL ? KF(g_pre_mix) + (layer + 1) * DM : nullptr;
            for (int m = gw; m < M; m += NGW) norm_row(karg_ptr<float>(offsetof(Args, out)) + (size_t)m * DM, y2 + (size_t)m * DM, KF(g_post_ffn) + layer * DM, karg_ptr<float>(offsetof(Args, out)) + (size_t)m * DM, gn, hbuf + (size_t)m * DM, g.lane);
            SEAM(pb + 8);
        }
    }
#undef IN
#undef SEAM
#undef KF
}
#undef ctl
#undef Wt_in
#undef Wt_br
#undef Wt_out
#undef Wt_f1
#undef Wt_f2
#undef hbuf
#undef z
#undef zg
#undef obuf
#undef mask
#undef kmean
#undef mf
#undef mb
#undef y1
#undef y2
#undef act

extern "C" void kernel_launch(void* const* d_in, const int* in_sizes, int n_in, void* d_out, int out_size, void* d_ws, size_t ws_size, hipStream_t stream) {
    static int grid = 0;
    if (grid == 0) {
        if (n_in != 19 || out_size != M * DM || ws_size < WS_NEED) { fprintf(stderr, "kernel_launch: unexpected shapes (n_in %d out %d ws %zu need %zu)\n", n_in, out_size, ws_size, (size_t)WS_NEED); grid = -1; return; }
        int dev = 0, cus = 0, per_cu = 0;
        if (hipGetDevice(&dev) != hipSuccess || hipDeviceGetAttribute(&cus, hipDeviceAttributeMultiprocessorCount, dev) != hipSuccess) { grid = -1; return; }
        if (hipFuncSetAttribute((const void*)trunk_fwd, hipFuncAttributeMaxDynamicSharedMemorySize, LDS_BYTES) != hipSuccess) { fprintf(stderr, "kernel_launch: hipFuncSetAttribute failed\n"); grid = -1; return; }
        if (hipOccupancyMaxActiveBlocksPerMultiprocessor(&per_cu, (const void*)trunk_fwd, 512, LDS_BYTES) != hipSuccess || per_cu < 1) { fprintf(stderr, "kernel_launch: occupancy query says %d\n", per_cu); }
        (void)hipGetLastError();
        grid = cus;
    }
    if (grid < 0) return;
    (void)hipMemsetAsync((char*)d_ws + WS_CTL, 0, CTL_BYTES, stream);
    Args a{};
    a.x = (const float*)d_in[0]; a.w_in = (const float*)d_in[1];
    a.w_br[0] = (const float*)d_in[2]; a.w_br[1] = (const float*)d_in[3]; a.w_br[2] = (const float*)d_in[4]; a.w_br[3] = (const float*)d_in[5];
    a.w_out = (const float*)d_in[6]; a.lq1 = (const float*)d_in[7]; a.lk1 = (const float*)d_in[8]; a.lq2 = (const float*)d_in[9]; a.lk2 = (const float*)d_in[10];
    a.subln = (const float*)d_in[11]; a.relb = (const float*)d_in[12]; a.w_f1 = (const float*)d_in[13]; a.w_f2 = (const float*)d_in[14];
    a.g_pre_mix = (const float*)d_in[15]; a.g_post_mix = (const float*)d_in[16]; a.g_pre_ffn = (const float*)d_in[17]; a.g_post_ffn = (const float*)d_in[18];
    a.out = (float*)d_out; a.ws = (unsigned char*)d_ws;
#if MK_ONE_LAUNCH
    a.ph_lo = 0; a.ph_hi = NPH;
    hipLaunchKernelGGL(trunk_fwd, dim3(grid), dim3(512), LDS_BYTES, stream, a);
#else
    for (int p = 0; p < NPH; ++p) { a.ph_lo = p; a.ph_hi = p + 1; hipLaunchKernelGGL(trunk_fwd, dim3(grid), dim3(512), LDS_BYTES, stream, a); }
#endif
}
```

```cpp
#include <hip/hip_runtime.h>
#include <cstdio>
#include <cstdint>

#ifndef MK_ONE_LAUNCH
#define MK_ONE_LAUNCH 1
#endif

#ifndef PROBE_DUP
#define PROBE_DUP 0
#endif
#ifndef PH_ENABLE
#define PH_ENABLE 0xFFFFFFFFu
#endif
#define PHEN(k) (((PH_ENABLE) >> (k)) & 1u)
#define DI __device__ __forceinline__
#define LAS __attribute__((address_space(3)))
typedef unsigned short bf16_t;
typedef short bf16x8 __attribute__((ext_vector_type(8)));
typedef short s16x4 __attribute__((ext_vector_type(4)));
typedef float f32x2 __attribute__((ext_vector_type(2)));
typedef float f32x4 __attribute__((ext_vector_type(4)));
typedef float f32x16 __attribute__((ext_vector_type(16)));
typedef unsigned u32x2 __attribute__((ext_vector_type(2)));
typedef unsigned u32x4 __attribute__((ext_vector_type(4)));
typedef __bf16 bf2_t __attribute__((ext_vector_type(2)));

constexpr int BATCH = 8, SEQ = 2048, DM = 1024, NL = 4, M = BATCH * SEQ;
constexpr int N_IN = 7752;
constexpr int NZ = 7936;
constexpr int NZG = 3840;
constexpr int DFF = 2816, NF1 = 2 * DFF;
constexpr float EPS = 1e-6f;
constexpr float LOG2E = 1.4426950408889634f;
constexpr int ZC_QSB = 0, ZC_KSB = 256, ZC_VSB = 512, ZC_QD = 768, ZC_KD = 1024, ZC_VD = 1280, ZC_QDS = 1536, ZC_KDS = 1792, ZC_VDS = 2048,
              ZC_QMB = 2304, ZC_KMB = 2560, ZC_VMB = 2816, ZC_QI = 3072, ZC_KI = 3584, ZC_WI = 3648;
constexpr int OC_SB = 0, OC_DF = 256, OC_DS = 512, OC_MB = 768;

constexpr size_t al256(size_t x) { return (x + 255) & ~(size_t)255; }
constexpr size_t WS_CTL = 0, CTL_BYTES = 1u << 20;
constexpr size_t SZ_WIN = (size_t)NL * NZ * DM * 2, SZ_WBR = (size_t)NL * 4 * DM * 256 * 2, SZ_WOUT = (size_t)NL * DM * DM * 2,
                 SZ_WF1 = (size_t)NL * NF1 * DM * 2, SZ_WF2 = (size_t)NL * DM * DFF * 2;
constexpr size_t WS_WIN = WS_CTL + CTL_BYTES;
constexpr size_t WS_WBR = WS_WIN + SZ_WIN;
constexpr size_t WS_WOUT = WS_WBR + SZ_WBR;
constexpr size_t WS_WF1 = WS_WOUT + SZ_WOUT;
constexpr size_t WS_WF2 = WS_WF1 + SZ_WF1;
constexpr size_t WS_H = WS_WF2 + SZ_WF2;
constexpr int NZQ = NZG, NZGW = 4096;
constexpr size_t WS_ZQ = WS_H + (size_t)M * DM * 2, SZ_ZQ = (size_t)M * NZQ * 2;
constexpr size_t WS_ZG = WS_ZQ + SZ_ZQ, SZ_ZG = (size_t)M * NZGW * 2;
constexpr size_t WS_O = WS_ZG + SZ_ZG;
constexpr size_t WS_MASK = WS_O + (size_t)M * DM * 2;
constexpr size_t WS_KMEAN = WS_MASK + (size_t)M * 256;
constexpr size_t WS_NEED = WS_KMEAN + (size_t)BATCH * 8 * 256 * 4;
constexpr size_t WS_MF = WS_ZQ;
constexpr size_t WS_MB = WS_ZQ + (size_t)M * DM * 4;
constexpr size_t WS_Y1 = WS_ZG;
constexpr size_t WS_ACT = WS_ZG;
constexpr size_t WS_Y2 = WS_ZQ;
static_assert((size_t)M * DM * 6 <= SZ_ZQ && (size_t)M * DFF * 2 <= SZ_ZG && (size_t)M * DM * 4 <= SZ_ZG, "overlays fit");

constexpr int CW_BAR = 4096;
constexpr int CW_QHEAD = 16384;
constexpr int CW_TMO = 16384 + 512;
constexpr int CW_IDXDONE = 16384 + 1024;
constexpr size_t CTL_KMEAN = 512 * 1024;
static_assert((CW_IDXDONE + 64 * NL * 64) * 4 <= (int)CTL_KMEAN && CTL_KMEAN + (size_t)NL * BATCH * 8 * 256 * 4 <= CTL_BYTES, "ctl map");

constexpr int LDS_SCR = 0, LDS_SCR_BYTES = 143360;
constexpr int SC_LD_BYTES = 16 * 2052 * 4;
constexpr int LDS_CTL = LDS_SCR_BYTES;
constexpr int LDS_BYTES = LDS_CTL + 256;

DI unsigned pk2(float lo, float hi) { f32x2 v = {lo, hi}; return __builtin_bit_cast(unsigned, __builtin_convertvector(v, bf2_t)); }
DI float bf2f(unsigned short b) { return __uint_as_float((unsigned)b << 16); }
DI float bflo(unsigned w) { return __uint_as_float(w << 16); }
DI float bfhi(unsigned w) { return __uint_as_float(w & 0xffff0000u); }
DI float ex2(float x) { return __builtin_amdgcn_exp2f(x); }
DI float lg2(float x) { return __builtin_amdgcn_logf(x); }
DI float rcpf(float x) { return __builtin_amdgcn_rcpf(x); }
DI float sigmoidf_(float x) { return rcpf(1.0f + ex2(-x * LOG2E)); }
DI float wave_sum(float v) {
#pragma unroll
    for (int o = 1; o < 64; o <<= 1) v += __shfl_xor(v, o);
    return v;
}
DI float other_half(float v) {
    auto rr = __builtin_amdgcn_permlane32_swap(__float_as_uint(v), __float_as_uint(v), false, false);
    return (threadIdx.x & 32) ? __uint_as_float(rr[0]) : __uint_as_float(rr[1]);
}

namespace pg8 {
constexpr int BM = 256, BK = 64, HALF = 128, HTB = HALF * BK * 2, STAGE_BYTES = 8 * HTB, NXCD = 8, WGM = 8;
__host__ __device__ __forceinline__ int lds_byte(int r, int c) { const int st = (r >> 4) * 2 + (c >> 5), rr = r & 15, cc = c & 31, ob = rr * 64 + cc * 2; return st * 1024 + (ob ^ (((ob >> 9) & 1) << 5)); }
__host__ __device__ __forceinline__ void stage_rc(int b, int& R, int& C) { const int st = b / 1024, sb = b % 1024, swz = sb ^ (((sb >> 9) & 1) << 5); R = (st >> 1) * 16 + swz / 64; C = (st & 1) * 32 + (swz % 64) / 2; }
__host__ __device__ __forceinline__ int perm32(int rho) { const int n = rho >> 4, i = rho & 15; return 8 * (i >> 2) + 4 * n + (i & 3); }
struct Unit { int pm, pn; };
struct Gemm { const bf16_t* A; const bf16_t* Bt; int M, N, K, lda, ldb; };
struct StaticOrder {
    int nM, nN, nwg, G, c;
    __host__ __device__ void init(int M_, int N_, int G_, int c_) { nM = M_ / BM; nN = N_ / BM; nwg = nM * nN; G = G_; c = c_; }
    __host__ __device__ bool next(int i, Unit& u) const {
        const long L = (long)i * G + c; if (L >= nwg) return false;
        int wgid = (int)L; { const int q = nwg / NXCD, r = nwg % NXCD, xcd = wgid % NXCD, off = wgid / NXCD; wgid = (xcd < r ? xcd * (q + 1) : r * (q + 1) + (xcd - r) * q) + off; }
        const int nig = WGM * nN, gid = wgid / nig, fm = gid * WGM, gsz = (nM - fm) < WGM ? (nM - fm) : WGM;
        u.pm = fm + ((wgid % nig) % gsz); u.pn = (wgid % nig) / gsz; return true;
    }
};
struct NoHook { static constexpr int EVERY = 0; template <class A> __device__ __forceinline__ void operator()(A&, const Unit&, int, int, int, int, int) const {} };
template <class Epi, class Hook = NoHook>
__device__ __forceinline__ void gemm_phase(LAS unsigned char* lds, Gemm g, const StaticOrder& S, const Epi& E, const Hook& H = Hook()) {
    { size_t zo = 0; asm volatile("" : "+s"(zo), "+s"(g.K), "+s"(g.lda), "+s"(g.ldb)); g.A += zo; g.Bt += zo; }
    int tid_ = threadIdx.x; asm volatile("" : "+v"(tid_));
    const int tid = tid_, wid = __builtin_amdgcn_readfirstlane(tid >> 6), lane = tid & 63, wr = wid >> 2, wc = wid & 3, fr = lane & 15, fq = lane >> 4;
    const int K = g.K, nt = K / BK;
    unsigned voffA[2], voffB[2];
#pragma unroll
    for (int i = 0; i < 2; ++i) { int R, C; stage_rc(tid * 16 + i * 8192, R, C); const int Rb = Epi::PERM ? ((R & ~31) + perm32(R & 31)) : R;
        voffA[i] = (unsigned)(R * g.lda + C) * 2u; voffB[i] = (unsigned)(Rb * g.ldb + C) * 2u; }
    const size_t kstep = (size_t)(BK * 2);
    const size_t hstepA = (size_t)HALF * g.lda * 2, hstepB = (size_t)HALF * g.ldb * 2;
    const size_t tstepA = 2 * hstepA, tstepB = 2 * hstepB;
    const unsigned ldsw = (unsigned)wid * 1024u;
    const int aoff = lds_byte(wr * 64 + fr, fq * 8), boff = lds_byte(wc * 32 + fr, fq * 8);
#define PG8_SA(b, h) (((b) * 2 + (h)) * HTB)
#define PG8_SB(b, h) ((4 + (b) * 2 + (h)) * HTB)
#define PG8_STAGE(bufoff, gbase, voff) do { _Pragma("unroll") for (int _i = 0; _i < 2; ++_i) \
        __builtin_amdgcn_global_load_lds((const unsigned*)((const char*)(gbase) + (voff)[_i]), (LAS unsigned*)(lds + (bufoff) + ldsw + _i * 8192), 16, 0, 0); } while (0)
#define PG8_LDA(dst, b, h) do { _Pragma("unroll") for (int m = 0; m < 4; ++m) _Pragma("unroll") for (int k = 0; k < 2; ++k) dst[m][k] = *(const LAS bf16x8*)(lds + PG8_SA(b, h) + aoff + m * 2048 + k * 1024); } while (0)
#define PG8_LDB(dst, b, h) do { _Pragma("unroll") for (int n = 0; n < 2; ++n) _Pragma("unroll") for (int k = 0; k < 2; ++k) dst[n][k] = *(const LAS bf16x8*)(lds + PG8_SB(b, h) + boff + n * 2048 + k * 1024); } while (0)
#define PG8_MMA(ai, bj, At, Bt) do { __builtin_amdgcn_s_setprio(1); _Pragma("unroll") for (int m = 0; m < 4; ++m) _Pragma("unroll") for (int n = 0; n < 2; ++n) _Pragma("unroll") for (int k = 0; k < 2; ++k) \
        acc[ai][bj][m][n] = __builtin_amdgcn_mfma_f32_16x16x32_bf16(Bt[n][k], At[m][k], acc[ai][bj][m][n], 0, 0, 0); __builtin_amdgcn_s_setprio(0); } while (0)
#define PG8_WAIT_V(n) asm volatile("s_waitcnt vmcnt(" #n ")" ::: "memory")
#define PG8_WAIT_L(n) asm volatile("s_waitcnt lgkmcnt(" #n ")" ::: "memory")
#define PG8_BAR __builtin_amdgcn_s_barrier()
#define PG8_SCHED __builtin_amdgcn_sched_barrier(0)
    Unit cur, nxt; int ui = 0;
    if (!S.next(0, cur)) return;
    f32x4 acc[2][2][4][2];
#pragma unroll
    for (int a = 0; a < 2; ++a)
#pragma unroll
        for (int b = 0; b < 2; ++b)
#pragma unroll
            for (int m = 0; m < 4; ++m)
#pragma unroll
                for (int n = 0; n < 2; ++n) acc[a][b][m][n] = (f32x4){0.f, 0.f, 0.f, 0.f};
    bf16x8 At[4][2], B0[2][2], B1[2][2];
    const char* cA = (const char*)g.A + (size_t)cur.pm * tstepA; const char* cB = (const char*)g.Bt + (size_t)cur.pn * tstepB;
    PG8_STAGE(PG8_SB(0, 0), cB, voffB); PG8_STAGE(PG8_SA(0, 0), cA, voffA); PG8_STAGE(PG8_SB(0, 1), cB + hstepB, voffB); PG8_STAGE(PG8_SA(0, 1), cA + hstepA, voffA);
    if (wr == 1) PG8_BAR;
    PG8_WAIT_V(4); PG8_BAR;
    PG8_STAGE(PG8_SB(1, 0), cB + kstep, voffB); PG8_STAGE(PG8_SA(1, 0), cA + kstep, voffA); PG8_STAGE(PG8_SB(1, 1), cB + hstepB + kstep, voffB);
    PG8_WAIT_V(6); PG8_BAR;
    for (;;) {
        const bool has_next = S.next(ui + 1, nxt);
        const char* nA = has_next ? (const char*)g.A + (size_t)nxt.pm * tstepA : cA; const char* nB = has_next ? (const char*)g.Bt + (size_t)nxt.pn * tstepB : cB;
        for (int t = 0; t < nt; t += 2) {
            const bool last = (t == nt - 2);
            const char* a1 = cA + (size_t)(t + 1) * kstep;
            const char* a2 = last ? nA : cA + (size_t)(t + 2) * kstep; const char* b2 = last ? nB : cB + (size_t)(t + 2) * kstep;
            const char* a3 = a2 + kstep; const char* b3 = b2 + kstep;
            PG8_LDB(B0, 0, 0); PG8_SCHED; PG8_LDA(At, 0, 0); PG8_STAGE(PG8_SA(1, 1), a1 + hstepA, voffA);
            PG8_WAIT_L(8); PG8_BAR; PG8_WAIT_L(0); PG8_MMA(0, 0, At, B0); PG8_BAR; PG8_SCHED;
            PG8_LDB(B1, 0, 1); PG8_STAGE(PG8_SB(0, 0), b2, voffB);
            PG8_BAR; PG8_WAIT_L(0); PG8_MMA(0, 1, At, B1); PG8_BAR;
            PG8_LDA(At, 0, 1); PG8_STAGE(PG8_SA(0, 0), a2, voffA);
            PG8_BAR; PG8_WAIT_L(0); PG8_MMA(1, 0, At, B0); PG8_BAR; PG8_SCHED;
            PG8_STAGE(PG8_SB(0, 1), b2 + hstepB, voffB);
            PG8_WAIT_V(6); PG8_BAR; PG8_MMA(1, 1, At, B1); PG8_BAR;
            PG8_LDB(B0, 1, 0); PG8_SCHED; PG8_LDA(At, 1, 0); PG8_STAGE(PG8_SA(0, 1), a2 + hstepA, voffA);
            PG8_WAIT_L(8); PG8_BAR; PG8_WAIT_L(0); PG8_MMA(0, 0, At, B0); PG8_BAR; PG8_SCHED;
            PG8_LDB(B1, 1, 1); PG8_STAGE(PG8_SB(1, 0), b3, voffB);
            PG8_BAR; PG8_WAIT_L(0); PG8_MMA(0, 1, At, B1); PG8_BAR;
            PG8_LDA(At, 1, 1); PG8_STAGE(PG8_SA(1, 0), a3, voffA);
            PG8_BAR; PG8_WAIT_L(0); PG8_MMA(1, 0, At, B0); PG8_BAR; PG8_SCHED;
            PG8_STAGE(PG8_SB(1, 1), b3 + hstepB, voffB);
            PG8_WAIT_V(6); PG8_BAR; PG8_MMA(1, 1, At, B1); PG8_BAR;
            if constexpr (Hook::EVERY > 0) { if (!last && ((t + 2) % Hook::EVERY) == 0) H(acc, cur, (t + 2) / Hook::EVERY - 1, wr, wc, fr, fq); }
        }
        E(acc, cur, wr, wc, fr, fq);
        if (!has_next) break;
#pragma unroll
        for (int a = 0; a < 2; ++a)
#pragma unroll
            for (int b = 0; b < 2; ++b)
#pragma unroll
                for (int m = 0; m < 4; ++m)
#pragma unroll
                    for (int n = 0; n < 2; ++n) acc[a][b][m][n] = (f32x4){0.f, 0.f, 0.f, 0.f};
        cur = nxt; cA = nA; cB = nB; ++ui;
    }
    PG8_WAIT_V(0);
    if (wr == 0) PG8_BAR;
    PG8_BAR;
#undef PG8_SA
#undef PG8_SB
#undef PG8_STAGE
#undef PG8_LDA
#undef PG8_LDB
#undef PG8_MMA
#undef PG8_WAIT_V
#undef PG8_WAIT_L
#undef PG8_BAR
#undef PG8_SCHED
}
}

struct EpiZ {
    static constexpr bool PERM = true;
    bf16_t* ZQ; bf16_t* ZG; float* KS;
    DI void operator()(const f32x4 (&acc)[2][2][4][2], const pg8::Unit& u, int wr, int wc, int fr, int fq) const {
        asm volatile("" : "+v"(fr), "+v"(fq));
        const bool gate = u.pn >= NZG / 256;
        if (u.pn == ZC_KMB / 256) {
#pragma unroll
            for (int bj = 0; bj < 2; ++bj)
#pragma unroll
                for (int n = 0; n < 2; ++n) { f32x4 cs = {0.f, 0.f, 0.f, 0.f};
#pragma unroll
                    for (int ai = 0; ai < 2; ++ai)
#pragma unroll
                        for (int m = 0; m < 4; ++m) cs += acc[ai][bj][m][n];
#pragma unroll
                    for (int j = 0; j < 4; ++j) { float v = cs[j]; v += __shfl_xor(v, 1); v += __shfl_xor(v, 2); v += __shfl_xor(v, 4); v += __shfl_xor(v, 8);
                        if (fr == 0) atomicAdd(KS + (size_t)u.pm * 256 + bj * 128 + wc * 32 + 8 * fq + 4 * n + j, v); } }
        }
        const int row0 = u.pm * 256 + wr * 64 + fr, col0 = (gate ? u.pn - NZG / 256 : u.pn) * 256 + wc * 32 + 8 * fq;
        bf16_t* Z = gate ? ZG : ZQ; const int ldz = gate ? NZGW : NZQ;
#pragma unroll
        for (int ai = 0; ai < 2; ++ai)
#pragma unroll
            for (int m = 0; m < 4; ++m) { bf16_t* rowp = Z + (size_t)(row0 + ai * 128 + m * 16) * ldz + col0;
#pragma unroll
                for (int bj = 0; bj < 2; ++bj) { f32x4 v0 = acc[ai][bj][m][0], v1 = acc[ai][bj][m][1];
                    if (gate) {
#pragma unroll
                        for (int j = 0; j < 4; ++j) { v0[j] = fmaxf(sigmoidf_(v0[j]), 1e-18f); v1[j] = fmaxf(sigmoidf_(v1[j]), 1e-18f); } }
                    u32x4 w; w.x = pk2(v0[0], v0[1]); w.y = pk2(v0[2], v0[3]); w.z = pk2(v1[0], v1[1]); w.w = pk2(v1[2], v1[3]);
                    *(u32x4*)(rowp + bj * 128) = w; } }
    }
};
struct MergeHook {
    static constexpr int EVERY = 4;
    const bf16_t* ZG;
    DI void operator()(f32x4 (&acc)[2][2][4][2], const pg8::Unit& u, int i, int wr, int wc, int fr, int fq) const {
        asm volatile("" : "+v"(fr), "+v"(fq));
        const int row0 = u.pm * 256 + wr * 64 + fr, col0 = u.pn * 256 + wc * 32 + 8 * fq;
        const bf16_t* gp = ZG + (size_t)row0 * NZGW + (size_t)i * 1024 + col0;
#pragma unroll
        for (int ai = 0; ai < 2; ++ai) {
            u32x4 ga[4][2], gb[4][2];
#pragma unroll
            for (int m = 0; m < 4; ++m)
#pragma unroll
                for (int bj = 0; bj < 2; ++bj) { const bf16_t* p = gp + (size_t)(ai * 128 + m * 16) * NZGW + bj * 128; ga[m][bj] = *(const u32x4*)p; gb[m][bj] = *(const u32x4*)(p + 1024); }
#pragma unroll
            for (int m = 0; m < 4; ++m)
#pragma unroll
                for (int bj = 0; bj < 2; ++bj) { const u32x4 a = ga[m][bj], b = gb[m][bj];
                    acc[ai][bj][m][0][0] *= bflo(a.x) * rcpf(bflo(b.x)); acc[ai][bj][m][0][1] *= bfhi(a.x) * rcpf(bfhi(b.x)); acc[ai][bj][m][0][2] *= bflo(a.y) * rcpf(bflo(b.y)); acc[ai][bj][m][0][3] *= bfhi(a.y) * rcpf(bfhi(b.y));
                    acc[ai][bj][m][1][0] *= bflo(a.z) * rcpf(bflo(b.z)); acc[ai][bj][m][1][1] *= bfhi(a.z) * rcpf(bfhi(b.z)); acc[ai][bj][m][1][2] *= bflo(a.w) * rcpf(bflo(b.w)); acc[ai][bj][m][1][3] *= bfhi(a.w) * rcpf(bfhi(b.w)); }
            asm volatile("" ::: "memory");
        }
    }
};
struct EpiMerge {
    static constexpr bool PERM = true;
    const bf16_t* ZG; bf16_t* MB;
    DI void operator()(const f32x4 (&acc)[2][2][4][2], const pg8::Unit& u, int wr, int wc, int fr, int fq) const {
        asm volatile("" : "+v"(fr), "+v"(fq));
        const int row0 = u.pm * 256 + wr * 64 + fr, col0 = u.pn * 256 + wc * 32 + 8 * fq;
#pragma unroll
        for (int ai = 0; ai < 2; ++ai)
#pragma unroll
            for (int m = 0; m < 4; ++m) { const size_t row = (size_t)(row0 + ai * 128 + m * 16);
#pragma unroll
                for (int bj = 0; bj < 2; ++bj) { const int col = col0 + bj * 128;
                    const u32x4 gw = *(const u32x4*)(ZG + row * NZGW + 3 * 1024 + col);
                    f32x4 v0 = acc[ai][bj][m][0], v1 = acc[ai][bj][m][1];
                    v0[0] *= bflo(gw.x); v0[1] *= bfhi(gw.x); v0[2] *= bflo(gw.y); v0[3] *= bfhi(gw.y);
                    v1[0] *= bflo(gw.z); v1[1] *= bfhi(gw.z); v1[2] *= bflo(gw.w); v1[3] *= bfhi(gw.w);
                    u32x4 w; w.x = pk2(v0[0], v0[1]); w.y = pk2(v0[2], v0[3]); w.z = pk2(v1[0], v1[1]); w.w = pk2(v1[2], v1[3]); *(u32x4*)(MB + row * DM + col) = w; }
                asm volatile("" ::: "memory"); }
    }
};
template <int BR> struct EpiBranch {
    static constexpr bool PERM = true;
    const bf16_t* Z; float* MF; bf16_t* MB;
    DI void operator()(const f32x4 (&acc)[2][2][4][2], const pg8::Unit& u, int wr, int wc, int fr, int fq) const {
        asm volatile("" : "+v"(fr), "+v"(fq));
        const int row0 = u.pm * 256 + wr * 64 + fr, col0 = u.pn * 256 + wc * 32 + 8 * fq;
#pragma unroll
        for (int ai = 0; ai < 2; ++ai)
#pragma unroll
            for (int m = 0; m < 4; ++m) { const size_t row = (size_t)(row0 + ai * 128 + m * 16);
#pragma unroll
                for (int bj = 0; bj < 2; ++bj) { const int col = col0 + bj * 128;
                    const u32x4 gw = *(const u32x4*)(Z + row * NZGW + BR * 1024 + col);
                    f32x4 v0 = acc[ai][bj][m][0], v1 = acc[ai][bj][m][1];
                    v0[0] *= bflo(gw.x); v0[1] *= bfhi(gw.x); v0[2] *= bflo(gw.y); v0[3] *= bfhi(gw.y);
                    v1[0] *= bflo(gw.z); v1[1] *= bfhi(gw.z); v1[2] *= bflo(gw.w); v1[3] *= bfhi(gw.w);
                    float* mp = MF + row * DM + col;
                    if (BR > 0) { v0 += *(const f32x4*)mp; v1 += *(const f32x4*)(mp + 4); }
                    if (BR < 3) { *(f32x4*)mp = v0; *(f32x4*)(mp + 4) = v1; }
                    else { u32x4 w; w.x = pk2(v0[0], v0[1]); w.y = pk2(v0[2], v0[3]); w.z = pk2(v1[0], v1[1]); w.w = pk2(v1[2], v1[3]); *(u32x4*)(MB + row * DM + col) = w; }
                    asm volatile("" ::: "memory"); } }
    }
};
struct EpiF32 {
    static constexpr bool PERM = false;
    float* C; int ldc;
    DI void operator()(const f32x4 (&acc)[2][2][4][2], const pg8::Unit& u, int wr, int wc, int fr, int fq) const {
        asm volatile("" : "+v"(fr), "+v"(fq));
        const int row0 = u.pm * 256 + wr * 64 + fr, col0 = u.pn * 256 + wc * 32 + 4 * fq;
#pragma unroll
        for (int ai = 0; ai < 2; ++ai)
#pragma unroll
            for (int m = 0; m < 4; ++m) { float* rowp = C + (size_t)(row0 + ai * 128 + m * 16) * ldc + col0;
#pragma unroll
                for (int bj = 0; bj < 2; ++bj)
#pragma unroll
                    for (int n = 0; n < 2; ++n) *(f32x4*)(rowp + bj * 128 + n * 16) = acc[ai][bj][m][n]; }
    }
};
struct EpiSwiglu {
    static constexpr bool PERM = true;
    bf16_t* ACT;
    DI void operator()(const f32x4 (&acc)[2][2][4][2], const pg8::Unit& u, int wr, int wc, int fr, int fq) const {
        asm volatile("" : "+v"(fr), "+v"(fq));
        const int row0 = u.pm * 256 + wr * 64 + fr, col0 = u.pn * 128 + wc * 32 + 8 * fq;
#pragma unroll
        for (int ai = 0; ai < 2; ++ai)
#pragma unroll
            for (int m = 0; m < 4; ++m) { bf16_t* rowp = ACT + (size_t)(row0 + ai * 128 + m * 16) * DFF + col0;
                float r[8];
#pragma unroll
                for (int n = 0; n < 2; ++n)
#pragma unroll
                    for (int j = 0; j < 4; ++j) { const float gt = acc[ai][0][m][n][j], up = acc[ai][1][m][n][j]; r[n * 4 + j] = gt * sigmoidf_(gt) * up; }
                u32x4 w; w.x = pk2(r[0], r[1]); w.y = pk2(r[2], r[3]); w.z = pk2(r[4], r[5]); w.w = pk2(r[6], r[7]);
                *(u32x4*)rowp = w; }
    }
};

#define XB_TMO      128
#define XB_XCNT(j)  (256  + 64 * (j))
#define XB_XSUB(j)  (1280 + 64 * (j))
#define XB_XGEN(j)  (2304 + 64 * (j))
#define XB_TOP      3328
#define XB_TOPGEN   3392
#define XCD_BAR_WORDS 3456
#define XB_SPIN_CAP (1u << 18)
__device__ __forceinline__ unsigned xb_ld(unsigned* p)              { return __hip_atomic_load(p, __ATOMIC_RELAXED, __HIP_MEMORY_SCOPE_AGENT); }
__device__ __forceinline__ unsigned xb_add(unsigned* p, unsigned v) { return __hip_atomic_fetch_add(p, v, __ATOMIC_RELAXED, __HIP_MEMORY_SCOPE_AGENT); }
__device__ __forceinline__ unsigned xb_xcc_id() { return (unsigned)__builtin_amdgcn_s_getreg((3 << 11) | 20) & 0xFu; }
#define XB_SPIN(cond, bar) do { unsigned _sp = 0; while (cond) { __builtin_amdgcn_s_sleep(1); \
    if ((++_sp & 255u) == 0u) { if (xb_ld(&(bar)[XB_TMO])) break; if (_sp > XB_SPIN_CAP) { atomicAdd(&(bar)[XB_TMO], 1u); break; } } } } while (0)
struct XcdBarrier { unsigned* bar; unsigned x; volatile LAS unsigned* st; };
__device__ __forceinline__ XcdBarrier xcd_barrier_post(unsigned* bar, volatile LAS unsigned* st) {
    XcdBarrier b; b.bar = bar; b.x = xb_xcc_id(); b.st = st;
    if (threadIdx.x == 0) (void)xb_add(&bar[XB_XCNT(b.x)], 1u);
    return b;
}
__device__ __forceinline__ void xcd_barrier_complete(unsigned* bar, unsigned x, unsigned& nloc, unsigned& nx) {
    const unsigned G = gridDim.x * gridDim.y * gridDim.z;
    unsigned sum, cnt, mine, sp = 0u;
    for (;;) {
        sum = 0u; cnt = 0u; mine = 0u;
#pragma unroll
        for (unsigned j = 0; j < 16; ++j) { const unsigned c = xb_ld(&bar[XB_XCNT(j)]); sum += c; cnt += (c > 0u) ? 1u : 0u; mine = (j == x) ? c : mine; }
        if (sum == G) break;
        __builtin_amdgcn_s_sleep(1);
        if ((++sp & 255u) == 0u) { if (xb_ld(&bar[XB_TMO])) break; if (sp > XB_SPIN_CAP) { atomicAdd(&bar[XB_TMO], 1u); break; } }
    }
    nloc = mine > 0u ? mine : 1u; nx = cnt > 0u ? cnt : 1u;
}
__device__ __forceinline__ void xcd_barrier(const XcdBarrier& b) {
    asm volatile("s_waitcnt vmcnt(0)" ::: "memory");
    __syncthreads();
    if (threadIdx.x == 0) {
        unsigned* bar = b.bar;
        __builtin_amdgcn_s_waitcnt(0);
        unsigned nloc = b.st[0], nx = b.st[1];
        if (nloc == 0u) { xcd_barrier_complete(bar, b.x, nloc, nx); b.st[0] = nloc; b.st[1] = nx; }
        const unsigned old = xb_add(&bar[XB_XSUB(b.x)], 1u);
        const unsigned gen = old / nloc;
        if (old + 1u == (gen + 1u) * nloc) {
            __builtin_amdgcn_fence(__ATOMIC_RELEASE, "agent");
            asm volatile("s_waitcnt vmcnt(0)" ::: "memory");
            const unsigned og = xb_add(&bar[XB_TOP], 1u);
            const unsigned tg = og / nx;
            if (og + 1u == (tg + 1u) * nx) xb_add(&bar[XB_TOPGEN], 1u);
            else XB_SPIN(xb_ld(&bar[XB_TOPGEN]) == tg, bar);
            __builtin_amdgcn_fence(__ATOMIC_ACQUIRE, "agent");
            xb_add(&bar[XB_XGEN(b.x)], 1u);
            asm volatile("s_waitcnt vmcnt(0)" ::: "memory");
        } else {
            XB_SPIN(xb_ld(&bar[XB_XGEN(b.x)]) == gen, bar);
            __builtin_amdgcn_fence(__ATOMIC_ACQUIRE, "agent");
            asm volatile("s_waitcnt vmcnt(0)" ::: "memory");
        }
    }
    __syncthreads();
}

DI size_t launder_off(size_t o) { asm volatile("" : "+s"(o)); return o; }
#define GAS __attribute__((address_space(1)))
#define CAS __attribute__((address_space(4)))
template <class T> DI T* karg_ptr(size_t off) { const CAS char* ka = (const CAS char*)__builtin_amdgcn_kernarg_segment_ptr(); return (T*)(*(GAS T* const CAS*)(ka + launder_off(off))); }
struct Args {
    const float* x; const float* w_in; const float* w_br[4]; const float* w_out;
    const float* lq1; const float* lk1; const float* lq2; const float* lk2; const float* subln; const float* relb;
    const float* w_f1; const float* w_f2; const float* g_pre_mix; const float* g_post_mix; const float* g_pre_ffn; const float* g_post_ffn;
    float* out; unsigned char* ws; int ph_lo, ph_hi;
};

template <class Map>
DI void conv_item(const float* W, int Nsrc, int K, bf16_t* WT, LAS float* scr, int kb, int nb, int lane, Map map) {
    const int k0 = 64 * kb, n0 = 32 * nb;
    int src; float sc; map(n0 + (lane & 31), src, sc);
#pragma unroll 8
    for (int i = 0; i < 32; ++i) { const int kk = 2 * i + (lane >> 5); scr[kk * 33 + (lane & 31)] = (src >= 0) ? W[(size_t)(k0 + kk) * Nsrc + src] * sc : 0.f; }
    asm volatile("s_waitcnt lgkmcnt(0)" ::: "memory");
    const int c = lane & 7;
#pragma unroll
    for (int j = 0; j < 4; ++j) { const int n = (lane >> 3) + 8 * j; const LAS float* s = scr + (8 * c) * 33 + n;
        u32x4 o; o.x = pk2(s[0 * 33], s[1 * 33]); o.y = pk2(s[2 * 33], s[3 * 33]); o.z = pk2(s[4 * 33], s[5 * 33]); o.w = pk2(s[6 * 33], s[7 * 33]);
        *(u32x4*)(WT + (size_t)(n0 + n) * K + k0 + 8 * c) = o; }
    asm volatile("s_waitcnt lgkmcnt(0)" ::: "memory");
}
struct MapIn {
    DI void operator()(int n, int& src, float& sc) const {
        const float QS = 0.125f * LOG2E;
        sc = 1.f;
        if (n < 768) { src = n; if (n < 256) sc = QS; }
        else if (n < 1024) { const int h = (n - 768) >> 6, j = (n - 768) & 63; src = j < 32 ? 768 + 32 * h + j : 896 + 32 * h + (j - 32); sc = 0.17677669529663687f * LOG2E; }
        else if (n < 1280) { const int h = (n - 1024) >> 6, j = (n - 1024) & 63; src = j < 32 ? 1024 + 32 * h + j : 1152 + 32 * h + (j - 32); }
        else if (n < 2304) { src = n; if (n >= 1536 && n < 1792) sc = QS; }
        else if (n < 3072) { src = n - 2304 + 2888; if (n < 2560) sc = QS; }
        else if (n < 3584) { src = n - 3072 + 2304; }
        else if (n < 3648) { src = n - 3584 + 2816; }
        else if (n < 3656) { src = n - 3648 + 2880; sc = 0.35355339059327373f * 0.125f; }
        else if (n < 3840) { src = -1; }
        else { src = n - 3840 + 3656; }
    }
};
struct MapId { DI void operator()(int n, int& src, float& sc) const { src = n; sc = 1.f; } };
struct MapF1 { DI void operator()(int n, int& src, float& sc) const { const int pn = n >> 8, j = n & 255; src = j < 128 ? 128 * pn + j : DFF + 128 * pn + (j - 128); sc = 1.f; } };

DI void norm_row(const float* xin, const float* y, const float* gpost, float* xout, const float* gnext, bf16_t* hout, int lane) {
    f32x4 xv[4];
#pragma unroll
    for (int j = 0; j < 4; ++j) xv[j] = *((const f32x4*)xin + lane + 64 * j);
    if (y) {
        f32x4 yv[4]; float s = 0.f;
#pragma unroll
        for (int j = 0; j < 4; ++j) { yv[j] = *((const f32x4*)y + lane + 64 * j); s += (yv[j][0] * yv[j][0] + yv[j][1] * yv[j][1]) + (yv[j][2] * yv[j][2] + yv[j][3] * yv[j][3]); }
        const float r = 1.0f / sqrtf(wave_sum(s) * (1.f / DM) + EPS);
#pragma unroll
        for (int j = 0; j < 4; ++j) { const f32x4 g = *((const f32x4*)gpost + lane + 64 * j); xv[j] = xv[j] + yv[j] * r * g; *((f32x4*)xout + lane + 64 * j) = xv[j]; }
    }
    if (gnext) {
        float s = 0.f;
#pragma unroll
        for (int j = 0; j < 4; ++j) s += (xv[j][0] * xv[j][0] + xv[j][1] * xv[j][1]) + (xv[j][2] * xv[j][2] + xv[j][3] * xv[j][3]);
        const float r = 1.0f / sqrtf(wave_sum(s) * (1.f / DM) + EPS);
#pragma unroll
        for (int j = 0; j < 4; ++j) { const f32x4 g = *((const f32x4*)gnext + lane + 64 * j); const f32x4 h = xv[j] * r * g;
            u32x2 w; w.x = pk2(h[0], h[1]); w.y = pk2(h[2], h[3]); *((u32x2*)hout + lane + 64 * j) = w; }
    }
}

#define MFMA32(a, b, c) __builtin_amdgcn_mfma_f32_32x32x16_bf16((a), (b), (c), 0, 0, 0)
#define MFMA16(a, b, c) __builtin_amdgcn_mfma_f32_16x16x32_bf16((a), (b), (c), 0, 0, 0)
struct Geo { int tid, lane, wid, r32, hi; };
DI Geo make_geo() { int t = threadIdx.x; asm volatile("" : "+v"(t)); Geo g; g.tid = t; g.lane = t & 63; g.wid = __builtin_amdgcn_readfirstlane(t >> 6); g.r32 = t & 31; g.hi = (t >> 5) & 1; return g; }
DI int crow(int i) { return (i & 3) + 8 * (i >> 2); }
constexpr float NEG_INF = -__builtin_inff();

DI void glds16(const void* gp, unsigned lds_base) {
    unsigned sv; asm volatile("s_mov_b32 %0, m0\n\ts_mov_b32 m0, %2\n\ts_nop 0\n\tglobal_load_lds_dwordx4 %1, off\n\ts_mov_b32 m0, %0" : "=&s"(sv) : "v"(gp), "s"(lds_base) : "memory"); }
DI unsigned lds_addr(const LAS unsigned char* p) { return (unsigned)__builtin_amdgcn_readfirstlane((int)(unsigned)(uintptr_t)p); }
DI void kv_stage(const bf16_t* Kg, const bf16_t* Vg, int key0, const Geo& g, LAS unsigned char* kb, LAS unsigned char* vb) {
    glds16(Kg + (size_t)(key0 + g.lane) * NZQ + g.wid * 8, lds_addr(kb + g.wid * 1024));
    glds16(Vg + (size_t)(key0 + 16 * (g.wid & 3) + (g.lane >> 2)) * NZQ + (g.wid >> 2) * 32 + (g.lane & 3) * 8, lds_addr(vb + g.wid * 1024));
}
template <int D0A, int D0B>
DI void qk_tile(const LAS unsigned char* kb, const bf16x8 (&qf)[4], const Geo& g, f32x16& s0, f32x16& s1) {
#pragma unroll
    for (int d0 = D0A; d0 < D0B; ++d0) {
        const bf16x8 k0 = *(const LAS bf16x8*)(kb + (2 * d0 + g.hi) * 1024 + g.r32 * 16);
        const bf16x8 k1 = *(const LAS bf16x8*)(kb + (2 * d0 + g.hi) * 1024 + 512 + g.r32 * 16);
        s0 = MFMA32(k0, qf[d0], s0); s1 = MFMA32(k1, qf[d0], s1);
    }
}
template <int D0A, int D0B>
DI void qk_tile_lq(const LAS unsigned char* kb, const LAS unsigned char* qs, const Geo& g, f32x16& s0, f32x16& s1) {
#pragma unroll
    for (int d0 = D0A; d0 < D0B; ++d0) {
        const bf16x8 q = *(const LAS bf16x8*)(qs + d0 * 1024);
        const bf16x8 k0 = *(const LAS bf16x8*)(kb + (2 * d0 + g.hi) * 1024 + g.r32 * 16);
        const bf16x8 k1 = *(const LAS bf16x8*)(kb + (2 * d0 + g.hi) * 1024 + 512 + g.r32 * 16);
        s0 = MFMA32(k0, q, s0); s1 = MFMA32(k1, q, s1);
    }
}
DI bf16x8 pack8(const f32x16& p, int s) {
    u32x4 w;
    if (s == 0) { w.x = pk2(p[0], p[1]); w.y = pk2(p[2], p[3]); w.z = pk2(p[4], p[5]); w.w = pk2(p[6], p[7]); }
    else { w.x = pk2(p[8], p[9]); w.y = pk2(p[10], p[11]); w.z = pk2(p[12], p[13]); w.w = pk2(p[14], p[15]); }
    return __builtin_bit_cast(bf16x8, w);
}
DI s16x4 vtr(const LAS unsigned char* p) { return __builtin_bit_cast(s16x4, __builtin_amdgcn_ds_read_tr16_b64_v4i16((LAS s16x4*)p)); }
DI void pv_tile(const LAS unsigned char* vb, const Geo& g, const f32x16& p0, const f32x16& p1, f32x16& o0, f32x16& o1) {
    const LAS unsigned char* vp = vb + ((g.lane >> 4) & 1) * 32 + (g.lane & 3) * 8 + (4 * g.hi + ((g.lane & 15) >> 2)) * 64;
#pragma unroll
    for (int ks = 0; ks < 4; ++ks) {
        const bf16x8 pf = pack8((ks & 2) ? p1 : p0, ks & 1);
        { const s16x4 lo = vtr(vp + ks * 1024), hh = vtr(vp + ks * 1024 + 512); const bf16x8 vf = __builtin_shufflevector(lo, hh, 0, 1, 2, 3, 4, 5, 6, 7); o0 = MFMA32(vf, pf, o0); }
        { const s16x4 lo = vtr(vp + 4096 + ks * 1024), hh = vtr(vp + 4096 + ks * 1024 + 512); const bf16x8 vf = __builtin_shufflevector(lo, hh, 0, 1, 2, 3, 4, 5, 6, 7); o1 = MFMA32(vf, pf, o1); }
    }
}
constexpr float RESC_THR = 8.0f;
DI bf16x8 ones_frag(int r32, int row) { const short v = (r32 == row) ? (short)0x3F80 : (short)0; bf16x8 f = {v, v, v, v, v, v, v, v}; return f; }
DI float rowmax32(const f32x16& s0, const f32x16& s1) {
    float a = fmaxf(fmaxf(s0[0], s0[1]), s1[0]), b = fmaxf(fmaxf(s0[2], s0[3]), s1[1]);
    a = fmaxf(fmaxf(a, s1[2]), s1[3]);
#pragma unroll
    for (int r = 4; r < 16; r += 4) { a = fmaxf(fmaxf(a, s0[r]), s0[r + 1]); b = fmaxf(fmaxf(b, s0[r + 2]), s0[r + 3]); a = fmaxf(fmaxf(a, s1[r]), s1[r + 1]); b = fmaxf(fmaxf(b, s1[r + 2]), s1[r + 3]); }
    return fmaxf(a, b);
}
template <int ROW>
DI void sm_tile(f32x16& s0, f32x16& s1, float c, float& m, f32x16& o0, f32x16& o1, f32x16& ol) {
    float mx = rowmax32(s0, s1); mx = fmaxf(mx, other_half(mx)) + c;
    if (__any(mx > m + RESC_THR)) {
        const float mn = fmaxf(m, mx), alpha = ex2(m - mn); m = mn;
#pragma unroll
        for (int i = 0; i < 16; ++i) { o0[i] *= alpha; o1[i] *= alpha; }
        ol[ROW] *= alpha;
    }
    const float sub = m - c;
#pragma unroll
    for (int i = 0; i < 16; ++i) { s0[i] = ex2(s0[i] - sub); s1[i] = ex2(s1[i] - sub); }
}
DI void sm_tile_l(f32x16& s0, f32x16& s1, float c, float& m, float& l, f32x16& o0, f32x16& o1) {
    float mx = rowmax32(s0, s1); mx = fmaxf(mx, other_half(mx)) + c;
    if (__any(mx > m + RESC_THR)) {
        const float mn = fmaxf(m, mx), alpha = ex2(m - mn); m = mn; l *= alpha;
#pragma unroll
        for (int i = 0; i < 16; ++i) { o0[i] *= alpha; o1[i] *= alpha; }
    }
    const float sub = m - c; float ra = 0.f, rb = 0.f;
#pragma unroll
    for (int i = 0; i < 16; ++i) { s0[i] = ex2(s0[i] - sub); s1[i] = ex2(s1[i] - sub); ra += s0[i]; rb += s1[i]; }
    l += ra + rb;
}
DI void pv_tile_sum(const LAS unsigned char* vb, const Geo& g, const f32x16& p0, const f32x16& p1, f32x16& o0, f32x16& o1, f32x16& ol, const bf16x8& ones) {
    const LAS unsigned char* vp = vb + ((g.lane >> 4) & 1) * 32 + (g.lane & 3) * 8 + (4 * g.hi + ((g.lane & 15) >> 2)) * 64;
#pragma unroll
    for (int ks = 0; ks < 4; ++ks) {
        const bf16x8 pf = pack8((ks & 2) ? p1 : p0, ks & 1);
        { const s16x4 lo = vtr(vp + ks * 1024), hh = vtr(vp + ks * 1024 + 512); const bf16x8 vf = __builtin_shufflevector(lo, hh, 0, 1, 2, 3, 4, 5, 6, 7); o0 = MFMA32(vf, pf, o0); }
        { const s16x4 lo = vtr(vp + 4096 + ks * 1024), hh = vtr(vp + 4096 + ks * 1024 + 512); const bf16x8 vf = __builtin_shufflevector(lo, hh, 0, 1, 2, 3, 4, 5, 6, 7); o1 = MFMA32(vf, pf, o1); }
        ol = MFMA32(ones, pf, ol);
    }
}
DI void fill_bias_table(LAS float* tb, const float* relb, int hcol, int tid) {
    if (tid < 128) { const int d = tid; int bk;
        if (d < 16) bk = d; else { const float lr = logf((float)d * (1.0f / 16.0f)) / 2.0794415416798357f; bk = 16 + (int)(lr * 16.0f); bk = bk < 31 ? bk : 31; }
        tb[d] = relb[bk * 12 + hcol] * LOG2E; }
}
template <class V>
DI void make_init(f32x16& i0, f32x16& i1, int kt, int qq, int hi, const LAS float* tb, V valid) {
    const int kb = 64 * kt + 4 * hi;
#pragma unroll
    for (int i = 0; i < 16; ++i) { const int d0 = qq - (kb + crow(i)), d1 = d0 - 32;
        const int c0 = d0 < 0 ? 0 : (d0 > 127 ? 127 : d0), c1 = d1 < 0 ? 0 : (d1 > 127 ? 127 : d1);
        const float b0 = tb[c0], b1 = tb[c1];
        i0[i] = valid(0, i, d0) ? b0 : NEG_INF; i1[i] = valid(1, i, d1) ? b1 : NEG_INF; }
}
DI void store_o(bf16_t* orow, int hi, const f32x16& o0, const f32x16& o1) {
#pragma unroll
    for (int g4 = 0; g4 < 4; ++g4) {
        u32x2 w0; w0.x = pk2(o0[4 * g4], o0[4 * g4 + 1]); w0.y = pk2(o0[4 * g4 + 2], o0[4 * g4 + 3]); *(u32x2*)(orow + 8 * g4 + 4 * hi) = w0;
        u32x2 w1; w1.x = pk2(o1[4 * g4], o1[4 * g4 + 1]); w1.y = pk2(o1[4 * g4 + 2], o1[4 * g4 + 3]); *(u32x2*)(orow + 32 + 8 * g4 + 4 * hi) = w1;
    }
}
DI void load_q(bf16x8 (&qf)[4], const bf16_t* qrow, int hi) {
#pragma unroll
    for (int d0 = 0; d0 < 4; ++d0) qf[d0] = *(const bf16x8*)(qrow + 16 * d0 + 8 * hi);
}
constexpr int AT_TB = 65536, AT_KM = 65536 + 512, AT_FLAG = 65536 + 512 + 2048;

template <bool REV, class F>
DI void kv_loop(const bf16_t* Kg, const bf16_t* Vg, int NT, LAS unsigned char* lds, const Geo& g, F&& tile) {
    kv_stage(Kg, Vg, 64 * (REV ? NT - 1 : 0), g, lds, lds + 8192);
    asm volatile("s_waitcnt vmcnt(0)" ::: "memory"); __syncthreads();
    for (int it = 0; it < NT; ++it) {
        const int kt = REV ? NT - 1 - it : it; const int buf = it & 1;
        if (it + 1 < NT) kv_stage(Kg, Vg, 64 * (REV ? kt - 1 : kt + 1), g, lds + (buf ^ 1) * 16384, lds + (buf ^ 1) * 16384 + 8192);
        tile(kt, (const LAS unsigned char*)(lds + buf * 16384), (const LAS unsigned char*)(lds + buf * 16384 + 8192));
        asm volatile("s_waitcnt vmcnt(0)" ::: "memory"); __syncthreads();
    }
}

constexpr float SB_CUT = 40.0f;
DI void sb_unit(const bf16_t* z, bf16_t* o, LAS unsigned char* lds, int b, int h, int qt) {
    const Geo g = make_geo();
    const size_t rb = (size_t)b * SEQ;
    const bf16_t* Kg = z + rb * NZQ + ZC_KSB + 64 * h; const bf16_t* Vg = z + rb * NZQ + ZC_VSB + 64 * h;
    const int q0w = 256 * qt + 32 * g.wid, qq = q0w + g.r32;
    bf16x8 qf[4]; load_q(qf, z + (rb + qq) * NZQ + ZC_QSB + 64 * h, g.hi);
    const int NT = 4 * qt + 4;
    f32x16 o0 = {}, o1 = {}; float R = 0.f;
    volatile LAS unsigned* ndone = (volatile LAS unsigned*)(lds + AT_FLAG);
    if (g.tid == 0) *ndone = 0u;
    bool wdone = false;
    kv_stage(Kg, Vg, 64 * (NT - 1), g, lds, lds + 8192);
    asm volatile("s_waitcnt vmcnt(0)" ::: "memory"); __syncthreads();
    for (int it = 0; it < NT; ++it) {
        const int kt = NT - 1 - it; const int buf = it & 1;
        if (it + 1 < NT) kv_stage(Kg, Vg, 64 * (kt - 1), g, lds + (buf ^ 1) * 16384, lds + (buf ^ 1) * 16384 + 8192);
        const LAS unsigned char* kb = lds + buf * 16384; const LAS unsigned char* vb = kb + 8192;
        if (!wdone && 64 * kt < q0w + 31) {
            f32x16 s0 = {}, s1 = {};
            qk_tile<0, 4>(kb, qf, g, s0, s1);
            const int kbase = 64 * kt + 4 * g.hi;
            f32x16 sp0, sp1;
#pragma unroll
            for (int i = 0; i < 16; ++i) {
                const bool v0 = (kbase + crow(i)) < qq, v1 = (kbase + 32 + crow(i)) < qq;
                const float z0 = s0[i], z1 = s1[i];
                const float a0 = fmaxf(z0, 0.f) + lg2(1.0f + ex2(-fabsf(z0))), a1 = fmaxf(z1, 0.f) + lg2(1.0f + ex2(-fabsf(z1)));
                sp0[i] = v0 ? a0 : 0.f; sp1[i] = v1 ? a1 : 0.f;
            }
            float gs[8], og[8];
#pragma unroll
            for (int q4 = 0; q4 < 4; ++q4) { gs[q4] = (sp0[4 * q4] + sp0[4 * q4 + 1]) + (sp0[4 * q4 + 2] + sp0[4 * q4 + 3]); gs[4 + q4] = (sp1[4 * q4] + sp1[4 * q4 + 1]) + (sp1[4 * q4 + 2] + sp1[4 * q4 + 3]); }
#pragma unroll
            for (int j = 0; j < 8; ++j) og[j] = other_half(gs[j]);
            float sg[8]; float run = 0.f;
#pragma unroll
            for (int j = 7; j >= 0; --j) {
                const float a1v = g.hi ? gs[j] : og[j], a0v = g.hi ? og[j] : gs[j];
                const float sg1 = run; run += a1v; const float sg0 = run; run += a0v;
                sg[j] = g.hi ? sg1 : sg0;
            }
#pragma unroll
            for (int q4 = 0; q4 < 4; ++q4) {
                {   const float t3 = R + sg[q4], t2 = t3 + sp0[4 * q4 + 3], t1 = t2 + sp0[4 * q4 + 2], t0 = t1 + sp0[4 * q4 + 1];
                    const float tt[4] = {t0, t1, t2, t3};
#pragma unroll
                    for (int e = 0; e < 4; ++e) { const int i = 4 * q4 + e; const bool v = (kbase + crow(i)) < qq; s0[i] = v ? ex2(s0[i] - sp0[i] - tt[e]) : 0.f; } }
                {   const float t3 = R + sg[4 + q4], t2 = t3 + sp1[4 * q4 + 3], t1 = t2 + sp1[4 * q4 + 2], t0 = t1 + sp1[4 * q4 + 1];
                    const float tt[4] = {t0, t1, t2, t3};
#pragma unroll
                    for (int e = 0; e < 4; ++e) { const int i = 4 * q4 + e; const bool v = (kbase + 32 + crow(i)) < qq; s1[i] = v ? ex2(s1[i] - sp1[i] - tt[e]) : 0.f; } }
            }
            R += run;
            pv_tile(vb, g, s0, s1, o0, o1);
            if (__all(R >= SB_CUT)) { wdone = true; if (g.lane == 0) __hip_atomic_fetch_add((LAS unsigned*)(lds + AT_FLAG), 1u, __ATOMIC_RELAXED, __HIP_MEMORY_SCOPE_WORKGROUP); }
        }
        asm volatile("s_waitcnt vmcnt(0) lgkmcnt(0)" ::: "memory"); __syncthreads();
        if (*ndone == 8u) break;
    }
    __syncthreads();
    store_o(o + (rb + qq) * DM + OC_SB + 64 * h, g.hi, o0, o1);
}

DI void k_stage(const bf16_t* Kg, int key0, const Geo& g, LAS unsigned char* kb) {
    glds16(Kg + (size_t)(key0 + g.lane) * NZQ + g.wid * 8, lds_addr(kb + g.wid * 1024));
}
DI void v_stage(const bf16_t* Vg, int key0, const Geo& g, LAS unsigned char* vb) {
    glds16(Vg + (size_t)(key0 + 16 * (g.wid & 3) + (g.lane >> 2)) * NZQ + (g.wid >> 2) * 32 + (g.lane & 3) * 8, lds_addr(vb + g.wid * 1024));
}
template <int D0A, int D0B> DI void k_frags(bf16x8 (&kf)[2 * (D0B - D0A)], const LAS unsigned char* kb, const Geo& g) {
#pragma unroll
    for (int d0 = D0A; d0 < D0B; ++d0) { kf[2 * (d0 - D0A)] = *(const LAS bf16x8*)(kb + (2 * d0 + g.hi) * 1024 + g.r32 * 16); kf[2 * (d0 - D0A) + 1] = *(const LAS bf16x8*)(kb + (2 * d0 + g.hi) * 1024 + 512 + g.r32 * 16); }
}
DI void v_frags_half(bf16x8 (&vf)[4], const LAS unsigned char* vb, const Geo& g) {
    const LAS unsigned char* vp = vb + ((g.lane >> 4) & 1) * 32 + (g.lane & 3) * 8 + (4 * g.hi + ((g.lane & 15) >> 2)) * 64;
#pragma unroll
    for (int i = 0; i < 4; ++i) { const s16x4 lo = vtr(vp + (i >> 1) * 4096 + (i & 1) * 1024), hh = vtr(vp + (i >> 1) * 4096 + (i & 1) * 1024 + 512); vf[i] = __builtin_shufflevector(lo, hh, 0, 1, 2, 3, 4, 5, 6, 7); }
}
DI float sm_max(float raw, float c, float& m, f32x16& o0, f32x16& o1, f32x16& ol) {
    const float mx = fmaxf(raw, other_half(raw)) + c;
    if (__any(mx > m + RESC_THR)) {
        const float mn = fmaxf(m, mx), alpha = ex2(m - mn); m = mn;
#pragma unroll
        for (int i = 0; i < 16; ++i) { o0[i] *= alpha; o1[i] *= alpha; }
        ol[0] *= alpha;
    }
    return m - c;
}
template <int D0A, int D0B, class Init>
DI void attn_pass(const bf16_t* Kg, const bf16_t* Vg, int NT, LAS unsigned char* lds, const Geo& g, const bf16x8 (&qf)[4], const bf16x8& ones,
                  float& m, f32x16& o0, f32x16& o1, f32x16& ol, Init init) {
    constexpr int NM = 2 * (D0B - D0A), EPG = 32 / NM;
    LAS unsigned char* KB = lds; LAS unsigned char* VB = lds + 32768;
    __builtin_amdgcn_s_waitcnt(0);
    k_stage(Kg, 0, g, KB); v_stage(Vg, 0, g, VB);
    k_stage(Kg, 64, g, KB + 8192); v_stage(Vg, 64, g, VB + 8192);
    k_stage(Kg, 128, g, KB + 16384);
    asm volatile("s_waitcnt vmcnt(0)" ::: "memory"); __builtin_amdgcn_s_barrier(); asm volatile("" ::: "memory");
    f32x16 sa0, sa1, sb0, sb1; float ca, cb = 0.f, rawa, rawb = NEG_INF;
    ca = init(0, sa0, sa1); qk_tile<D0A, D0B>(KB, qf, g, sa0, sa1); rawa = rowmax32(sa0, sa1);
#define ATT_ISSUE(t) do { if ((t) + 3 < NT) k_stage(Kg, 64 * ((t) + 3), g, KB + (((t) + 3) & 3) * 8192); if ((t) + 2 < NT) v_stage(Vg, 64 * ((t) + 2), g, VB + (((t) + 2) & 3) * 8192); } while (0)
#define ATT_CLOSE(t) do { if ((t) + 3 < NT) asm volatile("s_waitcnt vmcnt(2) lgkmcnt(0)" ::: "memory"); else asm volatile("s_waitcnt vmcnt(0) lgkmcnt(0)" ::: "memory"); \
        __builtin_amdgcn_s_barrier(); asm volatile("" ::: "memory"); } while (0)
#define ATT_FULL(SC0, SC1, CC, RAWC, SN0, SN1, CN, RAWN, t) do { \
        ATT_ISSUE(t); \
        bf16x8 kf_[NM]; k_frags<D0A, D0B>(kf_, KB + (((t) + 1) & 3) * 8192, g); \
        CN = init((t) + 1, SN0, SN1); \
        const float sub_ = sm_max(RAWC, CC, m, o0, o1, ol); \
        __builtin_amdgcn_sched_barrier(0); \
        _Pragma("unroll") for (int k_ = 0; k_ < NM; ++k_) { \
            if (k_ & 1) SN1 = MFMA32(kf_[k_], qf[D0A + (k_ >> 1)], SN1); else SN0 = MFMA32(kf_[k_], qf[D0A + (k_ >> 1)], SN0); \
            _Pragma("unroll") for (int e_ = 0; e_ < EPG; ++e_) { const int i_ = k_ * EPG + e_; if (i_ < 16) SC0[i_ & 15] = ex2(SC0[i_ & 15] - sub_); else SC1[i_ & 15] = ex2(SC1[i_ & 15] - sub_); } \
            __builtin_amdgcn_sched_barrier(0); } \
        { bf16x8 va_[4]; v_frags_half(va_, VB + ((t) & 3) * 8192, g); \
            const bf16x8 p0_ = pack8(SC0, 0), p1_ = pack8(SC0, 1), p2_ = pack8(SC1, 0), p3_ = pack8(SC1, 1); \
            __builtin_amdgcn_sched_barrier(0); \
            float xa_, xb_; \
            o0 = MFMA32(va_[0], p0_, o0); o1 = MFMA32(va_[2], p0_, o1); ol = MFMA32(ones, p0_, ol); \
            xa_ = fmaxf(fmaxf(SN0[0], SN0[1]), SN1[0]); xb_ = fmaxf(fmaxf(SN0[2], SN0[3]), SN1[1]); xa_ = fmaxf(fmaxf(xa_, SN1[2]), SN1[3]); \
            __builtin_amdgcn_sched_barrier(0); \
            o0 = MFMA32(va_[1], p1_, o0); o1 = MFMA32(va_[3], p1_, o1); ol = MFMA32(ones, p1_, ol); \
            xa_ = fmaxf(fmaxf(xa_, SN0[4]), SN0[5]); xb_ = fmaxf(fmaxf(xb_, SN0[6]), SN0[7]); xa_ = fmaxf(fmaxf(xa_, SN1[4]), SN1[5]); xb_ = fmaxf(fmaxf(xb_, SN1[6]), SN1[7]); \
            __builtin_amdgcn_sched_barrier(0); \
            bf16x8 vb_[4]; v_frags_half(vb_, VB + ((t) & 3) * 8192 + 2048, g); \
            xa_ = fmaxf(fmaxf(xa_, SN0[8]), SN0[9]); xb_ = fmaxf(fmaxf(xb_, SN0[10]), SN0[11]); xa_ = fmaxf(fmaxf(xa_, SN1[8]), SN1[9]); xb_ = fmaxf(fmaxf(xb_, SN1[10]), SN1[11]); \
            __builtin_amdgcn_sched_barrier(0); \
            o0 = MFMA32(vb_[0], p2_, o0); o1 = MFMA32(vb_[2], p2_, o1); ol = MFMA32(ones, p2_, ol); \
            xa_ = fmaxf(fmaxf(xa_, SN0[12]), SN0[13]); xb_ = fmaxf(fmaxf(xb_, SN0[14]), SN0[15]); xa_ = fmaxf(fmaxf(xa_, SN1[12]), SN1[13]); xb_ = fmaxf(fmaxf(xb_, SN1[14]), SN1[15]); \
            __builtin_amdgcn_sched_barrier(0); \
            o0 = MFMA32(vb_[1], p3_, o0); o1 = MFMA32(vb_[3], p3_, o1); ol = MFMA32(ones, p3_, ol); \
            RAWN = fmaxf(xa_, xb_); } \
        ATT_CLOSE(t); } while (0)
    for (int t = 0; t + 2 < NT; t += 2) {
        ATT_FULL(sa0, sa1, ca, rawa, sb0, sb1, cb, rawb, t);
        ATT_FULL(sb0, sb1, cb, rawb, sa0, sa1, ca, rawa, t + 1);
    }
    ATT_FULL(sa0, sa1, ca, rawa, sb0, sb1, cb, rawb, NT - 2);
    {
        const float sub_ = sm_max(rawb, cb, m, o0, o1, ol);
#pragma unroll
        for (int i = 0; i < 16; ++i) { sb0[i] = ex2(sb0[i] - sub_); sb1[i] = ex2(sb1[i] - sub_); }
        pv_tile_sum(VB + ((NT - 1) & 3) * 8192, g, sb0, sb1, o0, o1, ol, ones);
        asm volatile("s_waitcnt lgkmcnt(0)" ::: "memory"); __builtin_amdgcn_s_barrier(); asm volatile("" ::: "memory");
    }
#undef ATT_FULL
#undef ATT_CLOSE
#undef ATT_ISSUE
}

DI void diff_unit(const float* relb, const float* lq1, const float* lk1, const float* lq2, const float* lk2, const float* subln, const bf16_t* z, bf16_t* o, LAS unsigned char* lds, int layer, int b, int h, int qt) {
    const Geo g = make_geo();
    const size_t rb = (size_t)b * SEQ;
    const bf16_t* Kg = z + rb * NZQ + ZC_KD + 64 * h; const bf16_t* Vg = z + rb * NZQ + ZC_VD + 64 * h;
    const int q0w = 256 * qt + 32 * g.wid, qq = q0w + g.r32;
    LAS float* tb = (LAS float*)(lds + AT_TB);
    fill_bias_table(tb, relb, h, g.tid);
    bf16x8 qf[4]; load_q(qf, z + (rb + qq) * NZQ + ZC_QD + 64 * h, g.hi);
    const bf16x8 ones = ones_frag(g.r32, 0);
    const int NT = 4 * qt + 4;
    auto init = [&](int kt, f32x16& s0, f32x16& s1) -> float {
        if ((q0w - (64 * kt + 63)) >= 127) { s0 = f32x16{}; s1 = f32x16{}; return tb[127]; }
        make_init(s0, s1, kt, qq, g.hi, tb, [&](int, int, int dist) { return dist >= 0; }); return 0.f; };
    unsigned on[16];
    {   f32x16 o0 = {}, o1 = {}, ol = {}; float m = -1e30f;
        attn_pass<0, 2>(Kg, Vg, NT, lds, g, qf, ones, m, o0, o1, ol, init);
        float l = ol[0]; { const float x = other_half(l); if (g.hi) l = x; }
        const float il = 1.0f / l;
#pragma unroll
        for (int i = 0; i < 8; ++i) { on[i] = pk2(o0[2 * i] * il, o0[2 * i + 1] * il); on[8 + i] = pk2(o1[2 * i] * il, o1[2 * i + 1] * il); } }
    f32x16 o0 = {}, o1 = {}, ol = {}; float m = -1e30f;
    attn_pass<2, 4>(Kg, Vg, NT, lds, g, qf, ones, m, o0, o1, ol, init);
    float l2 = ol[0]; { const float x = other_half(l2); if (g.hi) l2 = x; }
    const int li = layer * 32 + g.r32;
    const float d1 = wave_sum(g.hi ? 0.f : lq1[li] * lk1[li]), d2 = wave_sum(g.hi ? 0.f : lq2[li] * lk2[li]);
    const float lam_init = 0.8f - 0.6f * expf(-0.3f * (float)layer);
    const float lam = expf(d1) - expf(d2) + lam_init;
    const float i2 = lam / l2;
    float ss = 0.f;
#pragma unroll
    for (int i = 0; i < 8; ++i) {
        o0[2 * i] = bflo(on[i]) - o0[2 * i] * i2; o0[2 * i + 1] = bfhi(on[i]) - o0[2 * i + 1] * i2;
        o1[2 * i] = bflo(on[8 + i]) - o1[2 * i] * i2; o1[2 * i + 1] = bfhi(on[8 + i]) - o1[2 * i + 1] * i2;
        ss += (o0[2 * i] * o0[2 * i] + o0[2 * i + 1] * o0[2 * i + 1]) + (o1[2 * i] * o1[2 * i] + o1[2 * i + 1] * o1[2 * i + 1]); }
    ss += other_half(ss);
    const float r = (1.0f - lam_init) / sqrtf(ss * (1.f / 64.f) + EPS);
    const float* sg = subln + launder_off((size_t)layer * 64);
#pragma unroll
    for (int i = 0; i < 16; ++i) { const int d = crow(i) + 4 * g.hi; o0[i] *= r * sg[d]; o1[i] *= r * sg[32 + d]; }
    store_o(o + (rb + qq) * DM + OC_DF + 64 * h, g.hi, o0, o1);
}

constexpr int AT_MASK = 69632;
static_assert(AT_MASK + 65536 <= LDS_SCR_BYTES && SC_LD_BYTES + 256 <= LDS_SCR_BYTES, "LDS map");
DI void dsa_unit(const float* relb, const bf16_t* z, const unsigned long long* mask, unsigned* done, unsigned* tmo, bf16_t* o, LAS unsigned char* lds, int b, int h, int qt) {
    const Geo g = make_geo();
    if (g.wid == 0) {
        unsigned spins = 0;
        while ((unsigned)__builtin_amdgcn_readfirstlane(__hip_atomic_load(done, __ATOMIC_RELAXED, __HIP_MEMORY_SCOPE_AGENT)) < 16u) {
            __builtin_amdgcn_s_sleep(2);
            if ((++spins & 1023u) == 0u) { if (__hip_atomic_load(tmo, __ATOMIC_RELAXED, __HIP_MEMORY_SCOPE_AGENT) != 0u) break; if (spins > (1u << 22)) { if (g.lane == 0) __hip_atomic_store(tmo, 1u, __ATOMIC_RELAXED, __HIP_MEMORY_SCOPE_AGENT); break; } }
        }
        __builtin_amdgcn_fence(__ATOMIC_ACQUIRE, "agent");
        asm volatile("s_waitcnt vmcnt(0)" ::: "memory");
    }
    __syncthreads();
    const size_t rb = (size_t)b * SEQ;
    const bf16_t* Kg = z + rb * NZQ + ZC_KDS + 64 * h; const bf16_t* Vg = z + rb * NZQ + ZC_VDS + 64 * h;
    const int q0w = 256 * qt + 32 * g.wid, qq = q0w + g.r32;
    LAS float* tb = (LAS float*)(lds + AT_TB);
    fill_bias_table(tb, relb, 4 + h, g.tid);
    LAS unsigned char* mrows = lds + AT_MASK + g.wid * 8192;
    { const u32x4* src = (const u32x4*)(mask + (rb + q0w) * 32);
#pragma unroll
      for (int i = 0; i < 8; ++i) *(LAS u32x4*)(mrows + (i * 64 + g.lane) * 16) = src[i * 64 + g.lane]; }
    bf16x8 qf[4]; load_q(qf, z + (rb + qq) * NZQ + ZC_QDS + 64 * h, g.hi);
    const bf16x8 ones = ones_frag(g.r32, 0);
    const LAS unsigned long long* mrow = (const LAS unsigned long long*)(mrows + g.r32 * 256);
    const int NT = 4 * qt + 4;
    f32x16 o0 = {}, o1 = {}, ol = {}; float m = -1e30f;
    attn_pass<0, 4>(Kg, Vg, NT, lds, g, qf, ones, m, o0, o1, ol,
        [&](int kt, f32x16& s0, f32x16& s1) -> float {
            unsigned long long mw = mrow[kt]; mw >>= (4 * g.hi);
            const unsigned mlo = (unsigned)mw, mhi = (unsigned)(mw >> 32);
            if ((q0w - (64 * kt + 63)) >= 127) {
                const unsigned bb = __float_as_uint(tb[127]);
#pragma unroll
                for (int i = 0; i < 16; ++i) {
                    const int e0 = ((int)(mlo << (31 - crow(i)))) >> 31, e1 = ((int)(mhi << (31 - crow(i)))) >> 31;
                    s0[i] = __uint_as_float((bb & (unsigned)e0) | (0xFF800000u & ~(unsigned)e0)); s1[i] = __uint_as_float((bb & (unsigned)e1) | (0xFF800000u & ~(unsigned)e1)); }
            } else make_init(s0, s1, kt, qq, g.hi, tb, [&](int n, int i, int) { return (((n ? mhi : mlo) >> crow(i)) & 1u) != 0u; });
            return 0.f; });
    float l = ol[0]; { const float x = other_half(l); if (g.hi) l = x; }
    const float il = 1.0f / l;
#pragma unroll
    for (int i = 0; i < 16; ++i) { o0[i] *= il; o1[i] *= il; }
    store_o(o + (rb + qq) * DM + OC_DS + 64 * h, g.hi, o0, o1);
}

DI void moba_unit(const float* relb, const bf16_t* z, const float* kmean, bf16_t* o, LAS unsigned char* lds, int b, int h, int qt) {
    const Geo g = make_geo();
    const size_t rb = (size_t)b * SEQ;
    const bf16_t* Kg = z + rb * NZQ + ZC_KMB + 64 * h; const bf16_t* Vg = z + rb * NZQ + ZC_VMB + 64 * h;
    const int q0w = 256 * qt + 32 * g.wid, qq = q0w + g.r32;
    LAS float* tb = (LAS float*)(lds + AT_TB); LAS float* km = (LAS float*)(lds + AT_KM);
    fill_bias_table(tb, relb, 8 + h, g.tid);
    { const int n = g.tid >> 6, d = g.tid & 63; km[g.tid] = kmean[((size_t)b * 8 + n) * 256 + 64 * h + d] * (1.0f / 256.0f); }
    bf16x8 qf[4]; load_q(qf, z + (rb + qq) * NZQ + ZC_QMB + 64 * h, g.hi);
    const bf16x8 ones = ones_frag(g.r32, 0);
    __syncthreads();
    const int own = qt;
    float gate[8];
#pragma unroll
    for (int n = 0; n < 7; ++n) { float p = 0.f;
        if (n < own) {
#pragma unroll
            for (int d0 = 0; d0 < 4; ++d0)
#pragma unroll
                for (int j = 0; j < 8; ++j) p += bf2f((unsigned short)qf[d0][j]) * km[n * 64 + 16 * d0 + 8 * g.hi + j];
            p += other_half(p); }
        gate[n] = p; }
    unsigned sel = 0u;
#pragma unroll
    for (int n = 0; n < 7; ++n) if (n < own) { int rank = 0;
#pragma unroll
        for (int n2 = 0; n2 < 7; ++n2) if (n2 < own && n2 != n) rank += (gate[n2] > gate[n] || (gate[n2] == gate[n] && n2 < n)) ? 1 : 0;
        if (rank < 3) sel |= 1u << n; }
    const int NT = 4 * qt + 4;
    f32x16 o0 = {}, o1 = {}, ol = {}; float m = -1e30f;
    attn_pass<0, 4>(Kg, Vg, NT, lds, g, qf, ones, m, o0, o1, ol,
        [&](int kt, f32x16& s0, f32x16& s1) -> float {
            const int blk = kt >> 2; const bool past = blk < own; const bool rowsel = ((sel >> blk) & 1u) != 0u;
            if ((q0w - (64 * kt + 63)) >= 127) { s0 = f32x16{}; s1 = f32x16{}; return (!past || rowsel) ? tb[127] : NEG_INF; }
            make_init(s0, s1, kt, qq, g.hi, tb, [&](int, int, int dist) { return past ? rowsel : dist >= 0; }); return 0.f; });
    float l = ol[0]; { const float x = other_half(l); if (g.hi) l = x; }
    const float il = 1.0f / l;
#pragma unroll
    for (int i = 0; i < 16; ++i) { o0[i] *= il; o1[i] *= il; }
    store_o(o + (rb + qq) * DM + OC_MB + 64 * h, g.hi, o0, o1);
}

constexpr int SC_LD = 2052;
constexpr int SEL_NB = 512, SEL_LCAP = 512;
DI float unkey(unsigned k) { return __uint_as_float((k & 0x80000000u) ? (k & 0x7FFFFFFFu) : ~k); }
DI unsigned okey(float x) { const unsigned u = __float_as_uint(x); return (u & 0x80000000u) ? ~u : (u | 0x80000000u); }
#ifndef PROBE_IDX_MODE
#define PROBE_IDX_MODE 0
#endif
template <int MODE> DI void idx_unit(const bf16_t* z, unsigned long long* mask, unsigned* done, LAS unsigned char* lds, int b, int qb) {
    const Geo g = make_geo();
    const size_t rb = (size_t)b * SEQ; const int q0 = 16 * qb;
    const int c = g.lane & 15, gq = g.lane >> 4;
    LAS float* sc = (LAS float*)lds;
    LAS unsigned* rmax = (LAS unsigned*)(lds + SC_LD_BYTES); LAS unsigned* rmin = rmax + 16;
    const int ntile = (q0 + 15) / 64 + 1;
    if (g.tid < 16) { rmax[g.tid] = 0u; rmin[g.tid] = 0xFFFFFFFFu; }
    __syncthreads();
    if (MODE != 2) {
        bf16x8 qf[8][2]; float wv[8];
        const bf16_t* qrow = z + (rb + q0 + c) * NZQ;
#pragma unroll
        for (int h8 = 0; h8 < 8; ++h8) {
            qf[h8][0] = *(const bf16x8*)(qrow + ZC_QI + 64 * h8 + 8 * gq); qf[h8][1] = *(const bf16x8*)(qrow + ZC_QI + 64 * h8 + 32 + 8 * gq);
            wv[h8] = bf2f(qrow[ZC_WI + h8]); }
        const int nt = ntile > g.wid ? (ntile - g.wid + 7) / 8 : 0;
        const bf16_t* kbase = z + (rb + c) * NZQ + ZC_KI + 8 * gq;
        bf16x8 kA[4][2], kB[4][2];
        unsigned kmx = 0u, kmn = 0xFFFFFFFFu;
#define IDX_LOAD(KF, i) do { const bf16_t* kr_ = kbase + (size_t)(64 * (g.wid + 8 * (i))) * NZQ; _Pragma("unroll") for (int k4 = 0; k4 < 4; ++k4) { KF[k4][0] = *(const bf16x8*)(kr_ + (size_t)(16 * k4) * NZQ); KF[k4][1] = *(const bf16x8*)(kr_ + (size_t)(16 * k4) * NZQ + 32); } } while (0)
#define IDX_COMP(KF, i) do { _Pragma("unroll") for (int k4 = 0; k4 < 4; ++k4) { f32x4 sacc = {0.f, 0.f, 0.f, 0.f}; \
            _Pragma("unroll") for (int h8 = 0; h8 < 8; ++h8) { f32x4 a = {0.f, 0.f, 0.f, 0.f}; a = MFMA16(KF[k4][0], qf[h8][0], a); a = MFMA16(KF[k4][1], qf[h8][1], a); \
                _Pragma("unroll") for (int e = 0; e < 4; ++e) sacc[e] += wv[h8] * fmaxf(a[e], 0.f); } \
            const int key0_ = 64 * (g.wid + 8 * (i)) + 16 * k4 + 4 * gq;        \
            *(LAS f32x4*)(sc + c * SC_LD + key0_) = sacc; \
            _Pragma("unroll") for (int e = 0; e < 4; ++e) { const unsigned ko = okey(sacc[e]); if (key0_ + e <= q0 + c) { kmx = ko > kmx ? ko : kmx; kmn = ko < kmn ? ko : kmn; } } } } while (0)
        if (nt > 0) IDX_LOAD(kA, 0);
        if (nt > 1) IDX_LOAD(kB, 1);
        for (int i = 0; i < nt; i += 2) {
            IDX_COMP(kA, i); if (i + 2 < nt) IDX_LOAD(kA, i + 2);
            if (i + 1 < nt) { IDX_COMP(kB, i + 1); if (i + 3 < nt) IDX_LOAD(kB, i + 3); }
        }
#undef IDX_LOAD
#undef IDX_COMP
        if (nt > 0) { __hip_atomic_fetch_max(rmax + c, kmx, __ATOMIC_RELAXED, __HIP_MEMORY_SCOPE_WORKGROUP); __hip_atomic_fetch_min(rmin + c, kmn, __ATOMIC_RELAXED, __HIP_MEMORY_SCOPE_WORKGROUP); }
    }
    __syncthreads();
    if (MODE == 1) return;
#define SB0() __builtin_amdgcn_sched_barrier(0)
#pragma unroll 1
    for (int rr = 0; rr < 2; ++rr) {
        const int row = 2 * g.wid + rr, q = q0 + row, n = q + 1;
        float x[32];
#pragma unroll
        for (int j = 0; j < 32; ++j) { const int key = 64 * j + g.lane; x[j] = key < n ? sc[row * SC_LD + key] : 0.f; }
        unsigned long long myw = 0ull;
        if (n <= 256) {
#pragma unroll
            for (int j = 0; j < 4; ++j) { const unsigned long long bl = __ballot(64 * j + g.lane < n); if (g.lane == j) myw = bl; SB0(); }
        } else {
            const float lo = unkey(rmin[row]), hi = unkey(rmax[row]);
            const float scale = hi > lo ? ((float)SEL_NB - 0.5f) / (hi - lo) : 0.f;
            LAS unsigned* hist = (LAS unsigned*)(sc + row * SC_LD); LAS u32x2* list = (LAS u32x2*)(hist + 512); LAS unsigned* bmap = hist + 1536; LAS unsigned* lcnt = hist + 1600;
            asm volatile("s_waitcnt lgkmcnt(0)" ::: "memory");
            *(LAS u32x4*)(hist + 8 * g.lane) = (u32x4){0u, 0u, 0u, 0u}; *(LAS u32x4*)(hist + 8 * g.lane + 4) = (u32x4){0u, 0u, 0u, 0u};
            bmap[g.lane] = 0u; if (g.lane == 0) *lcnt = 0u;
            int bk[32];
#pragma unroll
            for (int j = 0; j < 32; ++j) { const int key = 64 * j + g.lane; int bb = (int)((x[j] - lo) * scale); bb = bb > SEL_NB - 1 ? SEL_NB - 1 : bb; bk[j] = key < n ? bb : -1;
                if (key < n) __hip_atomic_fetch_add(hist + bb, 1u, __ATOMIC_RELAXED, __HIP_MEMORY_SCOPE_WORKGROUP); }
            const u32x4 ha = *(const LAS u32x4*)(hist + 8 * g.lane), hb = *(const LAS u32x4*)(hist + 8 * g.lane + 4);
            const unsigned hh[8] = {ha.x, ha.y, ha.z, ha.w, hb.x, hb.y, hb.z, hb.w};
            const unsigned tl = ((hh[0] + hh[1]) + (hh[2] + hh[3])) + ((hh[4] + hh[5]) + (hh[6] + hh[7]));
            unsigned suf = tl;
#pragma unroll
            for (int off = 1; off < 64; off <<= 1) { const unsigned v = __shfl_down(suf, off); if (g.lane + off < 64) suf += v; }
            const unsigned ex = suf - tl; const bool mine = ex < 256u && 256u <= suf;
            unsigned c_ = ex, d_ = 0u, ab_ = 0u, hs_ = 0u; bool fnd_ = false;
#pragma unroll
            for (int k = 7; k >= 0; --k) { if (!fnd_ && c_ + hh[k] >= 256u) { fnd_ = true; d_ = 8u * g.lane + k; ab_ = c_; hs_ = hh[k]; } if (!fnd_) c_ += hh[k]; }
            const int src = (int)__builtin_ctzll(__ballot(mine));
            const int B = (int)__shfl(d_, src); const int need = 256 - (int)__shfl(ab_, src); const int h = (int)__shfl(hs_, src);
            bool takeB = (h == need);
            unsigned thr = 0u; int tneed = 0; bool slow = false;
            if (!takeB) {
                if (h <= SEL_LCAP) {
#pragma unroll
                    for (int j = 0; j < 32; ++j) if (bk[j] == B) { const unsigned pos = __hip_atomic_fetch_add(lcnt, 1u, __ATOMIC_RELAXED, __HIP_MEMORY_SCOPE_WORKGROUP); list[pos] = (u32x2){okey(x[j]), (unsigned)(64 * j + g.lane)}; }
                    asm volatile("s_waitcnt lgkmcnt(0)" ::: "memory");
                    for (int e = g.lane; e < h; e += 64) {
                        const u32x2 me = list[e]; int rank = 0;
                        for (int i = 0; i < h; ++i) { const u32x2 ot = list[i]; rank += (ot.x > me.x || (ot.x == me.x && ot.y < me.y)) ? 1 : 0; }
                        if (rank < need) __hip_atomic_fetch_or(bmap + (me.y >> 5), 1u << (me.y & 31u), __ATOMIC_RELAXED, __HIP_MEMORY_SCOPE_WORKGROUP);
                    }
                } else {
                    slow = true; unsigned prefix = 0u;
#pragma unroll 1
                    for (int bit = 31; bit >= 0; --bit) { const unsigned cand = prefix | (1u << bit); int cnt = 0;
#pragma unroll
                        for (int j = 0; j < 32; ++j) { cnt += __popcll(__ballot(bk[j] == B && okey(x[j]) >= cand)); SB0(); }
                        if (cnt >= need) prefix = cand; }
                    thr = prefix; int cgt = 0;
#pragma unroll
                    for (int j = 0; j < 32; ++j) { cgt += __popcll(__ballot(bk[j] == B && okey(x[j]) > thr)); SB0(); }
                    tneed = need - cgt;
                }
            }
            asm volatile("s_waitcnt lgkmcnt(0)" ::: "memory");
#pragma unroll
            for (int j = 0; j < 32; ++j) {
                unsigned long long bl = __ballot(bk[j] > B || (takeB && bk[j] == B));
                if (slow) { bl |= __ballot(bk[j] == B && okey(x[j]) > thr); unsigned long long eq = __ballot(bk[j] == B && okey(x[j]) == thr);
                    int ce = __popcll(eq); while (ce > tneed) { eq &= ~(1ull << (63 - __clzll(eq))); --ce; } tneed -= ce; bl |= eq; }
                if (g.lane == j) myw = bl;
                SB0();
            }
            if (g.lane < 32) { const u32x2 bm = *(const LAS u32x2*)(bmap + 2 * g.lane); myw |= ((unsigned long long)bm.y << 32) | bm.x; }
        }
        if (MODE == 0) { if (g.lane < 32) __hip_atomic_store(mask + (rb + q) * 32 + g.lane, myw, __ATOMIC_RELAXED, __HIP_MEMORY_SCOPE_AGENT); }
        else if (myw == 0x123456789ull) __hip_atomic_store(mask, myw, __ATOMIC_RELAXED, __HIP_MEMORY_SCOPE_AGENT);
    }
#undef SB0
    asm volatile("s_waitcnt vmcnt(0)" ::: "memory");
    __syncthreads();
    if (MODE == 0 && g.tid == 0) __hip_atomic_fetch_add(done, 1u, __ATOMIC_RELAXED, __HIP_MEMORY_SCOPE_AGENT);
}

constexpr int NPH_LAYER = 8, NPH = 1 + NL * NPH_LAYER;
__global__ void __launch_bounds__(512, 2) trunk_fwd(Args A) {
#define KF(field) karg_ptr<const float>(offsetof(Args, field))
    extern __shared__ __attribute__((aligned(16))) unsigned char lds_raw[];
    LAS unsigned char* lds = (LAS unsigned char*)lds_raw;
    const int G = gridDim.x, bx = blockIdx.x;
#define ctl ((unsigned*)(karg_ptr<unsigned char>(offsetof(Args, ws)) + launder_off(WS_CTL)))
#define Wt_in ((bf16_t*)(karg_ptr<unsigned char>(offsetof(Args, ws)) + launder_off(WS_WIN)))
#define Wt_br ((bf16_t*)(karg_ptr<unsigned char>(offsetof(Args, ws)) + launder_off(WS_WBR)))
#define Wt_out ((bf16_t*)(karg_ptr<unsigned char>(offsetof(Args, ws)) + launder_off(WS_WOUT)))
#define Wt_f1 ((bf16_t*)(karg_ptr<unsigned char>(offsetof(Args, ws)) + launder_off(WS_WF1)))
#define Wt_f2 ((bf16_t*)(karg_ptr<unsigned char>(offsetof(Args, ws)) + launder_off(WS_WF2)))
#define hbuf ((bf16_t*)(karg_ptr<unsigned char>(offsetof(Args, ws)) + launder_off(WS_H)))
#define z ((bf16_t*)(karg_ptr<unsigned char>(offsetof(Args, ws)) + launder_off(WS_ZQ)))
#define zg ((bf16_t*)(karg_ptr<unsigned char>(offsetof(Args, ws)) + launder_off(WS_ZG)))
#define obuf ((bf16_t*)(karg_ptr<unsigned char>(offsetof(Args, ws)) + launder_off(WS_O)))
#define mask ((unsigned long long*)(karg_ptr<unsigned char>(offsetof(Args, ws)) + launder_off(WS_MASK)))
#define mf ((float*)(karg_ptr<unsigned char>(offsetof(Args, ws)) + launder_off(WS_MF)))
#define mb ((bf16_t*)(karg_ptr<unsigned char>(offsetof(Args, ws)) + launder_off(WS_MB)))
#define y1 ((float*)(karg_ptr<unsigned char>(offsetof(Args, ws)) + launder_off(WS_Y1)))
#define y2 ((float*)(karg_ptr<unsigned char>(offsetof(Args, ws)) + launder_off(WS_Y2)))
#define act ((bf16_t*)(karg_ptr<unsigned char>(offsetof(Args, ws)) + launder_off(WS_ACT)))
    if (threadIdx.x < 64) ((LAS unsigned*)(lds + LDS_CTL))[threadIdx.x] = 0u;
    __syncthreads();
#if MK_ONE_LAUNCH
    XcdBarrier bar = xcd_barrier_post(ctl + CW_BAR, (volatile LAS unsigned*)(lds + LDS_CTL));
#define GRID_BAR() xcd_barrier(bar)
#else
#define GRID_BAR() do { } while (0)
#endif
    const int lo = A.ph_lo, hi = A.ph_hi;
#define IN(k) (lo <= (k) && (k) < hi)
#define SEAM(k) do { if (IN((k) + 1)) GRID_BAR(); } while (0)

    if (PHEN(0) && IN(0)) {
        const Geo g = make_geo();
        LAS float* scr = (LAS float*)(lds + g.wid * 16384);
        const int gw = bx * 8 + g.wid, NGW = G * 8;
        constexpr int I_IN = 16 * (NZ / 32), I_BR = 4 * 4 * 32, I_OUT = 16 * 32, I_F1 = 16 * (NF1 / 32), I_F2 = (DFF / 64) * 32;
        constexpr int I_LAYER = I_IN + I_BR + I_OUT + I_F1 + I_F2;
        for (int rep = 0; rep < (((PROBE_DUP) >> 8) & 1 ? 2 : 1); ++rep)
        for (int it = gw; it < NL * I_LAYER; it += NGW) {
            const int l = it / I_LAYER; int r = it % I_LAYER;
            if (r < I_IN) { conv_item(KF(w_in) + (size_t)l * DM * N_IN, N_IN, DM, Wt_in + (size_t)l * NZ * DM, scr, r / (NZ / 32), r % (NZ / 32), g.lane, MapIn()); continue; } r -= I_IN;
            if (r < I_BR) { const int br = r / 128, rr = r % 128; conv_item(karg_ptr<const float>(offsetof(Args, w_br) + 8 * (size_t)br) + (size_t)l * 256 * DM, DM, DM, Wt_br + (size_t)l * DM * DM + 256 * br, scr, rr / 32, rr % 32, g.lane, MapId()); continue; } r -= I_BR;
            if (r < I_OUT) { conv_item(KF(w_out) + (size_t)l * DM * DM, DM, DM, Wt_out + (size_t)l * DM * DM, scr, r / 32, r % 32, g.lane, MapId()); continue; } r -= I_OUT;
            if (r < I_F1) { conv_item(KF(w_f1) + (size_t)l * DM * NF1, NF1, DM, Wt_f1 + (size_t)l * NF1 * DM, scr, r / (NF1 / 32), r % (NF1 / 32), g.lane, MapF1()); continue; } r -= I_F1;
            conv_item(KF(w_f2) + (size_t)l * DFF * DM, DM, DFF, Wt_f2 + (size_t)l * DM * DFF, scr, r / 32, r % 32, g.lane, MapId());
        }
        for (int m = gw; m < M; m += NGW) norm_row(KF(x) + (size_t)m * DM, nullptr, nullptr, nullptr, KF(g_pre_mix), hbuf + (size_t)m * DM, g.lane);
        SEAM(0);
    }

    for (int layer = 0; layer < NL; ++layer) {
        const int pb = 1 + layer * NPH_LAYER;
        if (PHEN(1) && IN(pb + 0)) {
            pg8::Gemm gm{hbuf, Wt_in + (size_t)layer * NZ * DM, M, NZ, DM, DM, DM}; pg8::StaticOrder S; S.init(M, NZ, G, bx);
            EpiZ E{z, zg, (float*)(karg_ptr<unsigned char>(offsetof(Args, ws)) + launder_off(CTL_KMEAN + (size_t)layer * BATCH * 8 * 256 * 4))}; for (int rep = 0; rep < (((PROBE_DUP) >> 0) & 1 ? 2 : 1); ++rep) pg8::gemm_phase(lds, gm, S, E);
            SEAM(pb + 0);
        }
        if (IN(pb + 1)) {
            const Geo g = make_geo();
            unsigned* qhead = ctl + CW_QHEAD + 64 * layer;
            volatile LAS unsigned* slot = (volatile LAS unsigned*)(lds + LDS_CTL + 64);
            constexpr int NITEM = 1024 + 768 + 256;
            for (int rep = 0; rep < (((PROBE_DUP) >> 1) & 1 ? 2 : 1); ++rep) {
            if (g.tid == 0) *slot = __hip_atomic_fetch_add(qhead, 1u, __ATOMIC_RELAXED, __HIP_MEMORY_SCOPE_AGENT);
            __syncthreads();
            int cur = (int)*slot - rep * (NITEM + G);
            while (cur < NITEM) {
                unsigned nxt = 0u;
                if (g.tid == 0) nxt = __hip_atomic_fetch_add(qhead, 1u, __ATOMIC_RELAXED, __HIP_MEMORY_SCOPE_AGENT);
                if (cur < 1024) { const int qb = 127 - (cur >> 3), b = cur & 7;
                    if (((PROBE_DUP) >> 15) & 1) idx_unit<PROBE_IDX_MODE>(z, mask, ctl + CW_IDXDONE + 64 * ((layer * 8 + b) * 8 + (qb >> 4)), lds, b, qb);
                    if (PHEN(4)) idx_unit<0>(z, mask, ctl + CW_IDXDONE + 64 * ((layer * 8 + b) * 8 + (qb >> 4)), lds, b, qb); }
                else if (cur < 1792) { const int j = cur - 1024, qt = 7 - j / 96, r = j % 96, kind = r >> 5, bh = r & 31, b = bh >> 2, h = bh & 3;
                    if (kind == 0) { for (int r2 = 0; r2 < (((PROBE_DUP) >> 11) & 1 ? 2 : 1); ++r2) if (PHEN(3)) diff_unit(KF(relb), KF(lq1), KF(lk1), KF(lq2), KF(lk2), KF(subln), z, obuf, lds, layer, b, h, qt); }
                    else if (kind == 1) { for (int r2 = 0; r2 < (((PROBE_DUP) >> 12) & 1 ? 2 : 1); ++r2) if (PHEN(7)) moba_unit(KF(relb), z, (const float*)(karg_ptr<unsigned char>(offsetof(Args, ws)) + launder_off(CTL_KMEAN + (size_t)layer * BATCH * 8 * 256 * 4)), obuf, lds, b, h, qt); }
                    else { for (int r2 = 0; r2 < (((PROBE_DUP) >> 13) & 1 ? 2 : 1); ++r2) if (PHEN(6)) dsa_unit(KF(relb), z, mask, ctl + CW_IDXDONE + 64 * ((layer * 8 + b) * 8 + qt), ctl + CW_TMO, obuf, lds, b, h, qt); } }
                else { const int j = cur - 1792, qt = 7 - (j >> 5), bh = j & 31;
                    for (int r2 = 0; r2 < (((PROBE_DUP) >> 14) & 1 ? 2 : 1); ++r2) if (PHEN(2)) sb_unit(z, obuf, lds, bh >> 2, bh & 3, qt); }
                __syncthreads();
                if (g.tid == 0) *slot = nxt;
                __syncthreads();
                cur = (int)*slot - rep * (NITEM + G);
            }
            if (((PROBE_DUP) >> 1) & 1) { GRID_BAR(); }
            }
            SEAM(pb + 1);
        }
        if (PHEN(8) && IN(pb + 2)) {
            for (int rep = 0; rep < (((PROBE_DUP) >> 3) & 1 ? 2 : 1); ++rep) {
            pg8::Gemm gm{obuf, Wt_br + (size_t)layer * DM * DM, M, DM, DM, DM, DM}; pg8::StaticOrder S; S.init(M, DM, G, bx);
            EpiMerge E{zg, mb}; MergeHook H{zg}; pg8::gemm_phase(lds, gm, S, E, H);
            }
            SEAM(pb + 2);
        }
        if (PHEN(9) && IN(pb + 3)) {
            pg8::Gemm gm{mb, Wt_out + (size_t)layer * DM * DM, M, DM, DM, DM, DM}; pg8::StaticOrder S; S.init(M, DM, G, bx);
            EpiF32 E{y1, DM}; for (int rep = 0; rep < (((PROBE_DUP) >> 4) & 1 ? 2 : 1); ++rep) pg8::gemm_phase(lds, gm, S, E);
            SEAM(pb + 3);
        }
        if (PHEN(10) && IN(pb + 4)) {
            const Geo g = make_geo();
            const int gw = bx * 8 + g.wid, NGW = G * 8;
            const float* xin = layer == 0 ? KF(x) : karg_ptr<float>(offsetof(Args, out));
            if (((PROBE_DUP) >> 5) & 1) for (int m = gw; m < M; m += NGW) norm_row(xin + (size_t)m * DM, y1 + (size_t)m * DM, KF(g_post_mix) + layer * DM, (float*)(karg_ptr<unsigned char>(offsetof(Args, ws)) + launder_off(WS_ZQ)) + (size_t)m * DM, KF(g_pre_ffn) + layer * DM, (bf16_t*)(karg_ptr<unsigned char>(offsetof(Args, ws)) + launder_off(WS_ZQ + (size_t)M * DM * 4)) + (size_t)m * DM, g.lane);
            for (int m = gw; m < M; m += NGW) norm_row(xin + (size_t)m * DM, y1 + (size_t)m * DM, KF(g_post_mix) + layer * DM, karg_ptr<float>(offsetof(Args, out)) + (size_t)m * DM, KF(g_pre_ffn) + layer * DM, hbuf + (size_t)m * DM, g.lane);
            SEAM(pb + 4);
        }
        if (PHEN(11) && IN(pb + 5)) {
            pg8::Gemm gm{hbuf, Wt_f1 + (size_t)layer * NF1 * DM, M, NF1, DM, DM, DM}; pg8::StaticOrder S; S.init(M, NF1, G, bx);
            EpiSwiglu E{act}; for (int rep = 0; rep < (((PROBE_DUP) >> 6) & 1 ? 2 : 1); ++rep) pg8::gemm_phase(lds, gm, S, E);
            SEAM(pb + 5);
        }
        if (PHEN(12) && IN(pb + 6)) {
            pg8::Gemm gm{act, Wt_f2 + (size_t)layer * DM * DFF, M, DM, DFF, DFF, DFF}; pg8::StaticOrder S; S.init(M, DM, G, bx);
            EpiF32 E{y2, DM}; for (int rep = 0; rep < (((PROBE_DUP) >> 7) & 1 ? 2 : 1); ++rep) pg8::gemm_phase(lds, gm, S, E);
            SEAM(pb + 6);
        }
        if (PHEN(10) && IN(pb + 7)) {
            const Geo g = make_geo();
            const int gw = bx * 8 + g.wid, NGW = G * 8;
            const float* gn = layer + 1 < NL ? KF(g_pre_mix) + (layer + 1) * DM : nullptr;
            if (((PROBE_DUP) >> 9) & 1) for (int m = gw; m < M; m += NGW) norm_row(karg_ptr<float>(offsetof(Args, out)) + (size_t)m * DM, y2 + (size_t)m * DM, KF(g_post_ffn) + layer * DM, (float*)(karg_ptr<unsigned char>(offsetof(Args, ws)) + launder_off(WS_ZG)) + (size_t)m * DM, gn, (bf16_t*)(karg_ptr<unsigned char>(offsetof(Args, ws)) + launder_off(WS_ZG + (size_t)M * DM * 4)) + (size_t)m * DM, g.lane);
            if (((PROBE_DUP) >> 10) & 1) { for (int i = 0; i < 8; ++i) GRID_BAR(); }
            for (int m = gw; m < M; m += NGW) norm_row(karg_ptr<float>(offsetof(Args, out)) + (size_t)m * DM, y2 + (size_t)m * DM, KF(g_post_ffn) + layer * DM, karg_ptr<float>(offsetof(Args, out)) + (size_t)m * DM, gn, hbuf + (size_t)m * DM, g.lane);
            SEAM(pb + 7);
        }
    }
#undef IN
#undef SEAM
#undef KF
}
#undef ctl
#undef Wt_in
#undef Wt_br
#undef Wt_out
#undef Wt_f1
#undef Wt_f2
#undef hbuf
#undef z
#undef zg
#undef obuf
#undef mask
#undef mf
#undef mb
#undef y1
#undef y2
#undef act

extern "C" void kernel_launch(void* const* d_in, const int* in_sizes, int n_in, void* d_out, int out_size, void* d_ws, size_t ws_size, hipStream_t stream) {
    static int grid = 0;
    if (grid == 0) {
        if (n_in != 19 || out_size != M * DM || ws_size < WS_NEED) { fprintf(stderr, "kernel_launch: unexpected shapes (n_in %d out %d ws %zu need %zu)\n", n_in, out_size, ws_size, (size_t)WS_NEED); grid = -1; return; }
        int dev = 0, cus = 0, per_cu = 0;
        if (hipGetDevice(&dev) != hipSuccess || hipDeviceGetAttribute(&cus, hipDeviceAttributeMultiprocessorCount, dev) != hipSuccess) { grid = -1; return; }
        if (hipFuncSetAttribute((const void*)trunk_fwd, hipFuncAttributeMaxDynamicSharedMemorySize, LDS_BYTES) != hipSuccess) { fprintf(stderr, "kernel_launch: hipFuncSetAttribute failed\n"); grid = -1; return; }
        if (hipOccupancyMaxActiveBlocksPerMultiprocessor(&per_cu, (const void*)trunk_fwd, 512, LDS_BYTES) != hipSuccess || per_cu < 1) { fprintf(stderr, "kernel_launch: occupancy query says %d\n", per_cu); }
        (void)hipGetLastError();
        grid = cus;
    }
    if (grid < 0) return;
    (void)hipMemsetAsync((char*)d_ws + WS_CTL, 0, CTL_BYTES, stream);
    Args a{};
    a.x = (const float*)d_in[0]; a.w_in = (const float*)d_in[1];
    a.w_br[0] = (const float*)d_in[2]; a.w_br[1] = (const float*)d_in[3]; a.w_br[2] = (const float*)d_in[4]; a.w_br[3] = (const float*)d_in[5];
    a.w_out = (const float*)d_in[6]; a.lq1 = (const float*)d_in[7]; a.lk1 = (const float*)d_in[8]; a.lq2 = (const float*)d_in[9]; a.lk2 = (const float*)d_in[10];
    a.subln = (const float*)d_in[11]; a.relb = (const float*)d_in[12]; a.w_f1 = (const float*)d_in[13]; a.w_f2 = (const float*)d_in[14];
    a.g_pre_mix = (const float*)d_in[15]; a.g_post_mix = (const float*)d_in[16]; a.g_pre_ffn = (const float*)d_in[17]; a.g_post_ffn = (const float*)d_in[18];
    a.out = (float*)d_out; a.ws = (unsigned char*)d_ws;
#if MK_ONE_LAUNCH
    a.ph_lo = 0; a.ph_hi = NPH;
    hipLaunchKernelGGL(trunk_fwd, dim3(grid), dim3(512), LDS_BYTES, stream, a);
#else
    for (int p = 0; p < NPH; ++p) { a.ph_lo = p; a.ph_hi = p + 1; hipLaunchKernelGGL(trunk_fwd, dim3(grid), dim3(512), LDS_BYTES, stream, a); }
#endif
}
```
